# Optimizing an MI355X kernel written in HIP

```python
import math
import jax, jax.numpy as jnp
from jax import lax
import numpy as np

D_MODEL = 1024
BATCH = 2
SEQ = 8192
DEPTH = 4
DEC_BATCH = 4
DEC_SEQ = 4096
PAST_LEN = 128

N_MIXERS = 2
N_ATTN_LAYERS = (DEPTH + N_MIXERS - 1) // N_MIXERS
N_SSM_LAYERS = DEPTH // N_MIXERS
ATTN_HEADS = 16
HEAD_DIM = 64
ATTN_WIDTH = ATTN_HEADS * HEAD_DIM
DILATED_PAIRS = ((128, 1), (512, 4), (2048, 16))
N_DIL = len(DILATED_PAIRS)
ATTN_IN = (3 * N_DIL + 1) * ATTN_WIDTH
ROPE_THETA = 10000.0
SSM_WIDTH = D_MODEL
GROUP_CH = 16
SSM_GROUPS = SSM_WIDTH // GROUP_CH
STATE = 64
DT_MIN = 0.001
DT_MAX = 0.1
LAMBDA_RE_MAX = -1e-4
NORM_EPS = 1e-6
NEG_INF = -1e30

kernel_name = "dilated_attn_s5_interleaved_adaln_encoder"


def rms_norm(x, g):
    x32 = x.astype(jnp.float32)
    y = x32 * lax.rsqrt(jnp.mean(x32 * x32, axis=-1, keepdims=True) + NORM_EPS)
    return (y * g.astype(jnp.float32)).astype(x.dtype)


def rope_tables(s):
    inv_freq = ROPE_THETA ** (-jnp.arange(0, HEAD_DIM, 2, dtype=jnp.float32) / HEAD_DIM)
    ang = jnp.arange(s, dtype=jnp.float32)[:, None] * inv_freq[None, :]
    return jnp.cos(ang)[:, None, :], jnp.sin(ang)[:, None, :]


def apply_rope(t, cos, sin):
    t32 = t.astype(jnp.float32)
    t1, t2 = jnp.split(t32, 2, axis=-1)
    out = jnp.concatenate([t1 * cos - t2 * sin, t2 * cos + t1 * sin], axis=-1)
    return out.astype(t.dtype)


def dilated_window_attention(q, k, v, dil, radius):
    bsz, s, h, e = q.shape
    blk = radius
    m = s // dil
    nb = -(-m // blk)
    mp = nb * blk

    def to_sub(t):
        return t.reshape(bsz, m, dil, h, e).transpose(0, 2, 3, 1, 4)

    qs = jnp.pad(to_sub(q), ((0, 0), (0, 0), (0, 0), (0, mp - m), (0, 0)))
    qs = qs.reshape(bsz, dil, h, nb, blk, e)

    def neighbours(t):
        tp = jnp.pad(to_sub(t), ((0, 0), (0, 0), (0, 0), (blk, mp - m + blk), (0, 0)))
        tp = tp.reshape(bsz, dil, h, nb + 2, blk, e)
        return jnp.concatenate([tp[:, :, :, :-2], tp[:, :, :, 1:-1], tp[:, :, :, 2:]], axis=4)

    kw = neighbours(k)
    vw = neighbours(v)
    qi = jnp.arange(nb)[:, None, None] * blk + jnp.arange(blk)[None, :, None]
    kj = jnp.arange(nb)[:, None, None] * blk - blk + jnp.arange(3 * blk)[None, None, :]
    valid = (jnp.abs(kj - qi) <= radius) & (kj >= 0) & (kj < m)

    scores = jnp.einsum('bdhnqe,bdhnke->bdhnqk', qs, kw).astype(jnp.float32)
    scores = jnp.where(valid, scores, NEG_INF)
    lse = jax.nn.logsumexp(scores, axis=-1)
    probs = jnp.exp(scores - lse[..., None]).astype(v.dtype)
    o = jnp.einsum('bdhnqk,bdhnke->bdhnqe', probs, vw)
    o = o.reshape(bsz, dil, h, mp, e)[:, :, :, :m].transpose(0, 3, 1, 2, 4).reshape(bsz, s, h, e)
    lse = lse.reshape(bsz, dil, h, mp)[:, :, :, :m].transpose(0, 3, 1, 2).reshape(bsz, s, h)
    return o, lse


def dilated_mixer(h, w_in, w_out):
    bsz, s, _ = h.shape
    proj = h @ w_in
    z = proj[..., 3 * N_DIL * ATTN_WIDTH:]
    cos, sin = rope_tables(s)
    scale = HEAD_DIM ** -0.5
    outs, lses = [], []
    for g, (window, dil) in enumerate(DILATED_PAIRS):
        qkv = proj[..., g * 3 * ATTN_WIDTH:(g + 1) * 3 * ATTN_WIDTH].reshape(bsz, s, 3, ATTN_HEADS, HEAD_DIM)
        q = apply_rope(qkv[:, :, 0], cos, sin) * scale
        k = apply_rope(qkv[:, :, 1], cos, sin)
        v = qkv[:, :, 2]
        o, lse = dilated_window_attention(q, k, v, dil, window // (2 * dil))
        outs.append(o)
        lses.append(lse)
    weights = jax.nn.softmax(jnp.stack(lses, axis=0), axis=0)
    o = jnp.einsum('gbsh,gbshe->bshe', weights.astype(h.dtype), jnp.stack(outs, axis=0))
    y = o.reshape(bsz, s, ATTN_WIDTH) * jax.nn.silu(z)
    return y @ w_out


def _linear_recurrence(e1, e2):
    a1, b1 = e1
    a2, b2 = e2
    return a1 * a2, a2 * b1 + b2


def s5_mixer(h, w_in, lam_re, lam_im, log_dt, b_re, b_im, c_re, c_im, d_skip, w_glu, w_out):
    bsz, s, _ = h.shape
    u, z = jnp.split(h @ w_in, 2, axis=-1)
    u32 = u.astype(jnp.float32)
    ug = u32.reshape(bsz, s, SSM_GROUPS, GROUP_CH)
    y = (d_skip.astype(jnp.float32) * u32).reshape(bsz, s, SSM_GROUPS, GROUP_CH)
    ugc = ug.astype(jnp.complex64)
    for direction in range(2):
        lam = lax.complex(jnp.minimum(lam_re[direction].astype(jnp.float32), LAMBDA_RE_MAX),
                          lam_im[direction].astype(jnp.float32))
        dt = jnp.exp(log_dt[direction].astype(jnp.float32))[:, None]
        lam_bar = jnp.exp(lam * dt)
        b_mat = lax.complex(b_re[direction].astype(jnp.float32), b_im[direction].astype(jnp.float32))
        b_bar = ((lam_bar - 1.0) / lam)[..., None] * b_mat
        bu = jnp.einsum('bsgc,gpc->bsgp', ugc, b_bar)
        a = jnp.broadcast_to(lam_bar, bu.shape)
        _, states = lax.associative_scan(_linear_recurrence, (a, bu), axis=1,
                                         reverse=(direction == 1))
        c_mat = lax.complex(c_re[direction].astype(jnp.float32), c_im[direction].astype(jnp.float32))
        y = y + jnp.real(jnp.einsum('bsgp,gcp->bsgc', states, c_mat))
    y = y.reshape(bsz, s, SSM_WIDTH).astype(h.dtype)
    g = jax.nn.gelu(y)
    y = g * jax.nn.sigmoid(g @ w_glu)
    return (y * jax.nn.silu(z)) @ w_out


def trunk(x, c, norm_g, ada_w, ada_b, attn_w_in, attn_w_out, ssm_w_in, ssm_lam_re, ssm_lam_im,
          ssm_log_dt, ssm_b_re, ssm_b_im, ssm_c_re, ssm_c_im, ssm_d, ssm_w_glu, ssm_w_out, final_norm_g):
    for i in range(DEPTH):
        ada = jax.nn.silu(c) @ ada_w[i] + ada_b[i]
        shift, scale, gate = jnp.split(ada[:, None, :], 3, axis=-1)
        hmod = rms_norm(x, norm_g[i]) * (1.0 + scale) + shift
        j = i // N_MIXERS
        if i % N_MIXERS == 0:
            out = dilated_mixer(hmod, attn_w_in[j], attn_w_out[j])
        else:
            out = s5_mixer(hmod, ssm_w_in[j], ssm_lam_re[j], ssm_lam_im[j], ssm_log_dt[j],
                           ssm_b_re[j], ssm_b_im[j], ssm_c_re[j], ssm_c_im[j], ssm_d[j],
                           ssm_w_glu[j], ssm_w_out[j])
        x = x + gate * out
    return rms_norm(x, final_norm_g)


def setup_inputs(seed: int = 0) -> dict:
    key = jax.random.key(seed)
    ks = jax.random.split(key, 24)
    f32 = jnp.float32

    def nrm(k, shape, s):
        return jax.random.normal(k, shape, f32) * s

    nA, nB = N_ATTN_LAYERS, N_SSM_LAYERS
    G, P, GC = SSM_GROUPS, STATE, GROUP_CH
    lam_im_base = jnp.broadcast_to(jnp.pi * jnp.arange(P, dtype=f32), (nB, 2, G, P))
    return {
        "x_prompt": nrm(ks[0], (BATCH, SEQ, D_MODEL), 1.0),
        "x_sample": nrm(ks[1], (DEC_BATCH, DEC_SEQ, D_MODEL), 1.0),
        "c_prompt": nrm(ks[2], (BATCH, D_MODEL), 1.0),
        "c_sample": nrm(ks[3], (DEC_BATCH, D_MODEL), 1.0),
        "norm_g": 1.0 + nrm(ks[4], (DEPTH, D_MODEL), 0.02),
        "ada_w": nrm(ks[5], (DEPTH, D_MODEL, 3 * D_MODEL), 0.5 * D_MODEL ** -0.5),
        "ada_b": nrm(ks[6], (DEPTH, 3 * D_MODEL), 0.02),
        "attn_w_in": nrm(ks[7], (nA, D_MODEL, ATTN_IN), D_MODEL ** -0.5),
        "attn_w_out": nrm(ks[8], (nA, ATTN_WIDTH, D_MODEL), ATTN_WIDTH ** -0.5),
        "ssm_w_in": nrm(ks[9], (nB, D_MODEL, 2 * SSM_WIDTH), D_MODEL ** -0.5),
        "ssm_lam_re": -0.5 + nrm(ks[10], (nB, 2, G, P), 0.01),
        "ssm_lam_im": lam_im_base + nrm(ks[11], (nB, 2, G, P), 0.01),
        "ssm_log_dt": jax.random.uniform(ks[12], (nB, 2, G), f32, math.log(DT_MIN), math.log(DT_MAX)),
        "ssm_b_re": nrm(ks[13], (nB, 2, G, P, GC), (2 * GC) ** -0.5),
        "ssm_b_im": nrm(ks[14], (nB, 2, G, P, GC), (2 * GC) ** -0.5),
        "ssm_c_re": nrm(ks[15], (nB, 2, G, GC, P), P ** -0.5),
        "ssm_c_im": nrm(ks[16], (nB, 2, G, GC, P), P ** -0.5),
        "ssm_d": nrm(ks[17], (nB, SSM_WIDTH), 0.5),
        "ssm_w_glu": nrm(ks[18], (nB, SSM_WIDTH, SSM_WIDTH), SSM_WIDTH ** -0.5),
        "ssm_w_out": nrm(ks[19], (nB, SSM_WIDTH, D_MODEL), SSM_WIDTH ** -0.5),
        "final_norm_g": 1.0 + nrm(ks[20], (D_MODEL,), 0.02),
    }


def reference(x_prompt, x_sample, c_prompt, c_sample, norm_g, ada_w, ada_b, attn_w_in, attn_w_out,
              ssm_w_in, ssm_lam_re, ssm_lam_im, ssm_log_dt, ssm_b_re, ssm_b_im, ssm_c_re, ssm_c_im,
              ssm_d, ssm_w_glu, ssm_w_out, final_norm_g):
    y_prompt = trunk(x_prompt, c_prompt, norm_g, ada_w, ada_b, attn_w_in, attn_w_out, ssm_w_in,
                     ssm_lam_re, ssm_lam_im, ssm_log_dt, ssm_b_re, ssm_b_im, ssm_c_re, ssm_c_im,
                     ssm_d, ssm_w_glu, ssm_w_out, final_norm_g)
    y_sample = trunk(x_sample, c_sample, norm_g, ada_w, ada_b, attn_w_in, attn_w_out, ssm_w_in,
                     ssm_lam_re, ssm_lam_im, ssm_log_dt, ssm_b_re, ssm_b_im, ssm_c_re, ssm_c_im,
                     ssm_d, ssm_w_glu, ssm_w_out, final_norm_g)
    return (y_prompt, y_sample)
```

```cpp
#include <hip/hip_runtime.h>
#include <hip/hip_cooperative_groups.h>
#include <cstdio>
#include <cstdint>
namespace cg = cooperative_groups;

typedef _Float16 h16;
typedef _Float16 half8 __attribute__((ext_vector_type(8)));
typedef _Float16 half4 __attribute__((ext_vector_type(4)));
typedef float f32x16 __attribute__((ext_vector_type(16)));
typedef float f32x4 __attribute__((ext_vector_type(4)));

#define NT 512
#define LAS __attribute__((address_space(3)))
#define MFMA32(a, b, c) __builtin_amdgcn_mfma_f32_32x32x16_f16(a, b, c, 0, 0, 0)
#define MFMA16(a, b, c) __builtin_amdgcn_mfma_f32_16x16x32_f16(a, b, c, 0, 0, 0)

constexpr int D = 1024;
constexpr int NTOK = 32768;
constexpr size_t MiB = 1024 * 1024;
constexpr size_t OFF_W = 0;
constexpr size_t OFF_ROPE = 24 * MiB;
constexpr size_t OFF_ADA = 26 * MiB;
constexpr size_t OFF_LSE = 27 * MiB;
constexpr size_t OFF_ENDS = 30 * MiB;
constexpr size_t OFF_BAR = 38 * MiB;
constexpr size_t OFF_R0 = 40 * MiB;
constexpr size_t OFF_BIG = 104 * MiB;
constexpr size_t OFF_QK = OFF_BIG;
constexpr size_t OFF_VT = OFF_BIG + 96 * MiB;
constexpr size_t OFF_ZC = OFF_BIG + 144 * MiB;
constexpr size_t OFF_O3 = OFF_BIG + 160 * MiB;
constexpr size_t OFF_R1 = OFF_BIG;
constexpr size_t OFF_R2 = OFF_BIG + 64 * MiB;
constexpr size_t OFF_R3 = OFF_BIG + 128 * MiB;
constexpr size_t WA_IN = 0;
constexpr size_t WA_OUT = (size_t)10240 * 1024;
constexpr size_t WS_IN = 0;
constexpr size_t WS_GLU = (size_t)2048 * 1024;
constexpr size_t WS_OUT = (size_t)3072 * 1024;

constexpr int ATT_LDS = 70656;
constexpr int SMEM_BYTES = 147456 + 16;

struct Params {
  const float *x_prompt, *x_sample, *c_prompt, *c_sample, *norm_g, *ada_w, *ada_b, *attn_w_in, *attn_w_out,
      *ssm_w_in, *lam_re, *lam_im, *log_dt, *b_re, *b_im, *c_re, *c_im, *ssm_d, *w_glu, *w_out, *final_g;
  float* out;
  char* ws;
};

__device__ __forceinline__ int otid() { int t = threadIdx.x; asm volatile("" : "+v"(t)); return t; }
__device__ __forceinline__ float afma(float a, float b, float c) { return __builtin_fmaf(a, b, c); }
__device__ __forceinline__ half8 pack8(f32x4 a, f32x4 b) { half8 o = {(h16)a[0], (h16)a[1], (h16)a[2], (h16)a[3], (h16)b[0], (h16)b[1], (h16)b[2], (h16)b[3]}; return o; }
__device__ __forceinline__ int obid() { int b = blockIdx.x; asm volatile("" : "+s"(b)); return b; }
__device__ __forceinline__ int ogdim() { int b = gridDim.x; asm volatile("" : "+s"(b)); return b; }
__device__ __forceinline__ half8 zero8() { float z = 0.f; asm volatile("" : "+v"(z)); f32x4 t = {z, z, z, z}; return __builtin_bit_cast(half8, t); }
__device__ __forceinline__ float shx(float v, int mask, int lane) { return __int_as_float(__builtin_amdgcn_ds_bpermute((lane ^ mask) << 2, __float_as_int(v))); }
__device__ __forceinline__ int seq_of_tok(int t) { return t < 16384 ? (t >> 13) : 2 + ((t - 16384) >> 12); }
__device__ __forceinline__ float silu_f(float x) { return x * __builtin_amdgcn_rcpf(1.f + __expf(-x)); }
__device__ __forceinline__ float sigmoid_f(float x) { return __builtin_amdgcn_rcpf(1.f + __expf(-x)); }
__device__ __forceinline__ float gelu_tanh(float x) {
  float u = 0.7978845608028654f * (x + 0.044715f * x * x * x);
  float t = 1.f - 2.f * __builtin_amdgcn_rcpf(1.f + __expf(2.f * u));
  return 0.5f * x * (1.f + t);
}

__device__ __forceinline__ void sincos_acc(float angf, float& s, float& c) {
  double a = (double)angf;
  double kd = rint(a * 0.6366197723675814);
  double r = a - kd * 1.5707963267948966 - kd * 6.123233995736766e-17;
  int k = ((int)kd) & 3;
  double r2 = r * r;
  double sp = r * (1.0 + r2 * (-1.0 / 6 + r2 * (1.0 / 120 + r2 * (-1.0 / 5040 + r2 * (1.0 / 362880 + r2 * (-1.0 / 39916800 + r2 * (1.0 / 6227020800.0)))))));
  double cp = 1.0 + r2 * (-0.5 + r2 * (1.0 / 24 + r2 * (-1.0 / 720 + r2 * (1.0 / 40320 + r2 * (-1.0 / 3628800 + r2 * (1.0 / 479001600 + r2 * (-1.0 / 87178291200.0)))))));
  double ss = (k & 1) ? cp : sp;
  double cc = (k & 1) ? sp : cp;
  if (k == 1) cc = -cc;
  if (k == 2) { ss = -ss; cc = -cc; }
  if (k == 3) ss = -ss;
  s = (float)ss;
  c = (float)cc;
}

__device__ __forceinline__ void convert_tile(const float* __restrict__ src, h16* __restrict__ dst, int N, int tile, char* smem) {
  float(*t)[129] = (float(*)[129])smem;
  const int ctid = otid();
  int ntn = N >> 7;
  int k0 = (tile / ntn) << 6, n0 = (tile % ntn) << 7;
  int tx = ctid & 31, ty = ctid >> 5;
#pragma unroll
  for (int i = 0; i < 4; ++i) {
    int k = ty + 16 * i;
    float4 v = *(const float4*)(src + (size_t)(k0 + k) * N + n0 + 4 * tx);
    t[k][4 * tx + 0] = v.x; t[k][4 * tx + 1] = v.y; t[k][4 * tx + 2] = v.z; t[k][4 * tx + 3] = v.w;
  }
  __syncthreads();
#pragma unroll
  for (int i = 0; i < 2; ++i) {
    int idx = ctid + 512 * i;
    int nn = idx >> 3, kc = idx & 7;
    half8 o;
#pragma unroll
    for (int j = 0; j < 8; ++j) o[j] = (h16)t[kc * 8 + j][nn];
    *(half8*)(dst + (size_t)(n0 + nn) * 1024 + k0 + kc * 8) = o;
  }
  __syncthreads();
}

__device__ __forceinline__ void convert_layer_weights(const Params& p, int layer, int item0, int nitems_before, char* smem) {
  h16* W = (h16*)(p.ws + OFF_W);
  int j = layer >> 1;
  if ((layer & 1) == 0) {
    const int n_in = 16 * 80, n_out = 128;
    for (int it = item0; it < nitems_before + n_in + n_out; it += ogdim()) {
      int t = it - nitems_before;
      if (t < 0) continue;
      if (t < n_in) convert_tile(p.attn_w_in + (size_t)j * 1024 * 10240, W + WA_IN, 10240, t, smem);
      else convert_tile(p.attn_w_out + (size_t)j * 1024 * 1024, W + WA_OUT, 1024, t - n_in, smem);
    }
  } else {
    const int n_in = 16 * 16, n_g = 128, n_o = 128;
    for (int it = item0; it < nitems_before + n_in + n_g + n_o; it += ogdim()) {
      int t = it - nitems_before;
      if (t < 0) continue;
      if (t < n_in) convert_tile(p.ssm_w_in + (size_t)j * 1024 * 2048, W + WS_IN, 2048, t, smem);
      else if (t < n_in + n_g) convert_tile(p.w_glu + (size_t)j * 1024 * 1024, W + WS_GLU, 1024, t - n_in, smem);
      else convert_tile(p.w_out + (size_t)j * 1024 * 1024, W + WS_OUT, 1024, t - n_in - n_g, smem);
    }
  }
}

__device__ __forceinline__ void phase0(const Params& p, char* smem) {
  const int tid = otid(); const int lane = tid & 63, wave = tid >> 6;
  const int N_ADA = 192, N_ROPE = 512;
  float* ADA = (float*)(p.ws + OFF_ADA);
  float2* ROPE = (float2*)(p.ws + OFF_ROPE);
  int it = obid();
  for (; it < N_ADA; it += ogdim()) {
    int layer = it / 48, cb = it % 48;
    float* sc = (float*)smem;
    float* red = (float*)(smem + 6 * 1024 * 4);
    for (int i = tid; i < 6144; i += NT) {
      int s = i >> 10, k = i & 1023;
      float c = s < 2 ? p.c_prompt[s * 1024 + k] : p.c_sample[(s - 2) * 1024 + k];
      sc[i] = silu_f(c);
    }
    __syncthreads();
    int col = cb * 64 + lane;
    float acc[6] = {0.f, 0.f, 0.f, 0.f, 0.f, 0.f};
    const float* wp = p.ada_w + ((size_t)layer * 1024 + wave * 128) * 3072 + col;
#pragma unroll 8
    for (int k = 0; k < 128; ++k) {
      float wv = wp[(size_t)k * 3072];
#pragma unroll
      for (int s = 0; s < 6; ++s) acc[s] += sc[s * 1024 + wave * 128 + k] * wv;
    }
#pragma unroll
    for (int s = 0; s < 6; ++s) red[(wave * 6 + s) * 64 + lane] = acc[s];
    __syncthreads();
    if (wave == 0) {
#pragma unroll
      for (int s = 0; s < 6; ++s) {
        float v = 0.f;
#pragma unroll
        for (int w8 = 0; w8 < 8; ++w8) v += red[(w8 * 6 + s) * 64 + lane];
        ADA[(layer * 6 + s) * 3072 + col] = v + p.ada_b[layer * 3072 + col];
      }
    }
    __syncthreads();
  }
  for (; it < N_ADA + N_ROPE; it += ogdim()) {
    int idx = (it - N_ADA) * NT + tid;
    int pos = idx >> 5, e = idx & 31;
    float invf = (float)exp(-(double)(2 * e) / 64.0 * 9.210340371976184);
    float ang = (float)pos * invf;
    float s, c;
    sincos_acc(ang, s, c);
    ROPE[idx] = make_float2(c, s);
  }
  convert_layer_weights(p, 0, it, N_ADA + N_ROPE, smem);
}

__device__ __forceinline__ void phase_norm(const Params& p, int layer, char* smem) {
  const int tid = otid(); const int lane = tid & 63, wave = tid >> 6;
  h16* H = (h16*)(p.ws + OFF_R0);
  const float* ADA = (const float*)(p.ws + OFF_ADA);
  const float* g = p.norm_g + layer * 1024;
  int it = obid();
  if (layer == 0) {
    auto rowptr = [&](int row) -> const float4* { return (const float4*)(row < 16384 ? p.x_prompt + (size_t)row * 1024 : p.x_sample + (size_t)(row - 16384) * 1024); };
    float4 gg[4], sh[4], scl[4];
#pragma unroll
    for (int j = 0; j < 4; ++j) gg[j] = *(const float4*)(g + 4 * (lane + 64 * j));
    int cur_seq = -1;
    float4 vn[4];
    if (it < NTOK / 8) {
      const float4* xr = rowptr(it * 8 + wave);
#pragma unroll
      for (int j = 0; j < 4; ++j) vn[j] = xr[lane + 64 * j];
    }
    for (; it < NTOK / 8; it += ogdim()) {
      const int row = it * 8 + wave;
      float4 v[4];
#pragma unroll
      for (int j = 0; j < 4; ++j) v[j] = vn[j];
      const int itn = it + ogdim();
      if (itn < NTOK / 8) {
        const float4* xr = rowptr(itn * 8 + wave);
#pragma unroll
        for (int j = 0; j < 4; ++j) vn[j] = xr[lane + 64 * j];
      }
      const int seq = seq_of_tok(row);
      if (seq != cur_seq) {
        cur_seq = seq;
        const float* ada = ADA + (layer * 6 + seq) * 3072;
#pragma unroll
        for (int j = 0; j < 4; ++j) { sh[j] = *(const float4*)(ada + 4 * (lane + 64 * j)); scl[j] = *(const float4*)(ada + 1024 + 4 * (lane + 64 * j)); }
      }
      float ss = 0.f;
#pragma unroll
      for (int j = 0; j < 4; ++j) ss += v[j].x * v[j].x + v[j].y * v[j].y + v[j].z * v[j].z + v[j].w * v[j].w;
#pragma unroll
      for (int o = 32; o >= 1; o >>= 1) ss += shx(ss, o, lane);
      float rstd = rsqrtf(ss * (1.f / 1024.f) + 1e-6f);
#pragma unroll
      for (int j = 0; j < 4; ++j) {
        int idx = 4 * (lane + 64 * j);
        half4 o;
        o[0] = (h16)(v[j].x * rstd * gg[j].x * (1.f + scl[j].x) + sh[j].x);
        o[1] = (h16)(v[j].y * rstd * gg[j].y * (1.f + scl[j].y) + sh[j].y);
        o[2] = (h16)(v[j].z * rstd * gg[j].z * (1.f + scl[j].z) + sh[j].z);
        o[3] = (h16)(v[j].w * rstd * gg[j].w * (1.f + scl[j].w) + sh[j].w);
        *(half4*)(H + (size_t)row * 1024 + idx) = o;
      }
    }
  } else {
    const h16* X16 = (const h16*)p.out;
    f32x4 gg[2][2], sh[2][2], scl[2][2];
#pragma unroll
    for (int j = 0; j < 2; ++j)
#pragma unroll
      for (int n = 0; n < 2; ++n) gg[j][n] = *(const f32x4*)(g + 8 * (lane + 64 * j) + 4 * n);
    int cur_seq = -1;
    half8 vn[2];
    if (it < NTOK / 8) {
#pragma unroll
      for (int j = 0; j < 2; ++j) vn[j] = *(const half8*)(X16 + (size_t)(it * 8 + wave) * 1024 + 8 * (lane + 64 * j));
    }
    for (; it < NTOK / 8; it += ogdim()) {
      const int row = it * 8 + wave;
      half8 v[2];
#pragma unroll
      for (int j = 0; j < 2; ++j) v[j] = vn[j];
      const int itn = it + ogdim();
      if (itn < NTOK / 8) {
#pragma unroll
        for (int j = 0; j < 2; ++j) vn[j] = *(const half8*)(X16 + (size_t)(itn * 8 + wave) * 1024 + 8 * (lane + 64 * j));
      }
      const int seq = seq_of_tok(row);
      if (seq != cur_seq) {
        cur_seq = seq;
        const float* ada = ADA + (layer * 6 + seq) * 3072;
#pragma unroll
        for (int j = 0; j < 2; ++j)
#pragma unroll
          for (int n = 0; n < 2; ++n) { sh[j][n] = *(const f32x4*)(ada + 8 * (lane + 64 * j) + 4 * n); scl[j][n] = *(const f32x4*)(ada + 1024 + 8 * (lane + 64 * j) + 4 * n); }
      }
      f32x4 f[2][2];
      float ss = 0.f;
#pragma unroll
      for (int j = 0; j < 2; ++j)
#pragma unroll
        for (int n = 0; n < 2; ++n)
#pragma unroll
          for (int k = 0; k < 4; ++k) { const float t = (float)v[j][4 * n + k]; f[j][n][k] = t; ss += t * t; }
#pragma unroll
      for (int o = 32; o >= 1; o >>= 1) ss += shx(ss, o, lane);
      const float rstd = rsqrtf(ss * (1.f / 1024.f) + 1e-6f);
#pragma unroll
      for (int j = 0; j < 2; ++j) {
        const f32x4 lo = f[j][0] * rstd * gg[j][0] * (scl[j][0] + 1.f) + sh[j][0];
        const f32x4 hi = f[j][1] * rstd * gg[j][1] * (scl[j][1] + 1.f) + sh[j][1];
        *(half8*)(H + (size_t)row * 1024 + 8 * (lane + 64 * j)) = pack8(lo, hi);
      }
    }
  }
  if (layer > 0) convert_layer_weights(p, layer, it, NTOK / 8, smem);
}

__device__ __forceinline__ void phase_final_norm(const Params& p) {
  const int tid = otid(); const int lane = tid & 63, wave = tid >> 6;
  const h16* X16 = (const h16*)(p.ws + OFF_R3);
  f32x4 gg[2][2];
#pragma unroll
  for (int j = 0; j < 2; ++j)
#pragma unroll
    for (int n = 0; n < 2; ++n) gg[j][n] = *(const f32x4*)(p.final_g + 8 * (lane + 64 * j) + 4 * n);
  int it = obid();
  half8 vn[2];
  if (it < NTOK / 8) {
#pragma unroll
    for (int j = 0; j < 2; ++j) vn[j] = *(const half8*)(X16 + (size_t)(it * 8 + wave) * 1024 + 8 * (lane + 64 * j));
  }
  for (; it < NTOK / 8; it += ogdim()) {
    const int row = it * 8 + wave;
    half8 v[2];
#pragma unroll
    for (int j = 0; j < 2; ++j) v[j] = vn[j];
    const int itn = it + ogdim();
    if (itn < NTOK / 8) {
#pragma unroll
      for (int j = 0; j < 2; ++j) vn[j] = *(const half8*)(X16 + (size_t)(itn * 8 + wave) * 1024 + 8 * (lane + 64 * j));
    }
    f32x4 f[2][2];
    float ss = 0.f;
#pragma unroll
    for (int j = 0; j < 2; ++j)
#pragma unroll
      for (int n = 0; n < 2; ++n)
#pragma unroll
        for (int k = 0; k < 4; ++k) { const float t = (float)v[j][4 * n + k]; f[j][n][k] = t; ss += t * t; }
#pragma unroll
    for (int o = 32; o >= 1; o >>= 1) ss += shx(ss, o, lane);
    const float rstd = rsqrtf(ss * (1.f / 1024.f) + 1e-6f);
    float* xo = p.out + (size_t)row * 1024;
#pragma unroll
    for (int j = 0; j < 2; ++j)
#pragma unroll
      for (int n = 0; n < 2; ++n) *(f32x4*)(xo + 8 * (lane + 64 * j) + 4 * n) = f[j][n] * rstd * gg[j][n];
  }
}

namespace pg8 {
constexpr int BK = 64, HALF = 128, HTB = HALF * BK * 2, STAGE_BYTES = 8 * HTB;
enum { PK_NONE = 0, PK_P32 = 1, PK_ROPE = 2 };
__device__ __forceinline__ int lds_byte(int r, int c) { const int st = (r >> 4) * 2 + (c >> 5), rr = r & 15, cc = c & 31, ob = rr * 64 + cc * 2; return st * 1024 + (ob ^ (((ob >> 9) & 1) << 5)); }
__device__ __forceinline__ void stage_rc(int b, int& R, int& C) { const int st = b / 1024, sb = b % 1024, swz = sb ^ (((sb >> 9) & 1) << 5); R = (st >> 1) * 16 + swz / 64; C = (st & 1) * 32 + (swz % 64) / 2; }
__device__ __forceinline__ int perm_row(int R, int kind) {
  if (kind == PK_P32) { const int rho = R & 31, n = rho >> 4, i = rho & 15; return (R & ~31) + 8 * (i >> 2) + 4 * n + (i & 3); }
  if (kind == PK_ROPE) { const int rho = R & 31, n = rho >> 4, i = rho & 15; return 2 * (R & ~31) + 8 * (i >> 2) + 4 * n + (i & 3); }
  return R;
}
struct Unit { const char* A; const char* B; unsigned ldb; int pkind; int kind; int pm; int pn; int aux; };
__device__ __forceinline__ void tile_of(int L, int nM, int nN, int& pm, int& pn) {
  const int nwg = nM * nN; int wgid = L;
  { const int q = nwg / 8, r = nwg % 8, xcd = wgid % 8, off = wgid / 8; wgid = (xcd < r ? xcd * (q + 1) : r * (q + 1) + (xcd - r) * q) + off; }
  const int nig = 8 * nN, gid = wgid / nig, fm = gid * 8, gsz = (nM - fm) < 8 ? (nM - fm) : 8;
  pm = fm + ((wgid % nig) % gsz); pn = (wgid % nig) / gsz;
}

template <class Epi, class Sched>
__device__ __forceinline__ void gemm_phase(LAS unsigned char* lds, const Sched& S, const Epi& E, const int tid) {
  const int wid = __builtin_amdgcn_readfirstlane(tid >> 6), lane = tid & 63, wr = wid >> 2, wc = wid & 3, fr = lane & 15, fq = lane >> 4;
  constexpr int K = 1024, nt = K / BK;
  unsigned voffA[2];
#pragma unroll
  for (int i = 0; i < 2; ++i) { int sR, sC; stage_rc(tid * 16 + i * 8192, sR, sC); voffA[i] = (unsigned)(sR * K + sC) * 2u; }
  const size_t kstep = (size_t)(BK * 2);
  const size_t hstepA = (size_t)HALF * K * 2;
  const unsigned ldsw = (unsigned)wid * 1024u;
  const int aoff = lds_byte(wr * 64 + fr, fq * 8), boff = lds_byte(wc * 32 + fr, fq * 8);
#define PG8_SA(b, h) (((b) * 2 + (h)) * HTB)
#define PG8_SB(b, h) ((4 + (b) * 2 + (h)) * HTB)
#define PG8_STAGE(bufoff, gbase, voff) do { _Pragma("unroll") for (int _i = 0; _i < 2; ++_i) \
    __builtin_amdgcn_global_load_lds((const unsigned*)((const char*)(gbase) + (voff)[_i]), (LAS unsigned*)(lds + (bufoff) + ldsw + _i * 8192), 16, 0, 0); } while (0)
#define PG8_LDA(dst, b, h) do { _Pragma("unroll") for (int m = 0; m < 4; ++m) _Pragma("unroll") for (int k = 0; k < 2; ++k) dst[m][k] = *(const LAS half8*)(lds + PG8_SA(b, h) + aoff + m * 2048 + k * 1024); } while (0)
#define PG8_LDB(dst, b, h) do { _Pragma("unroll") for (int n = 0; n < 2; ++n) _Pragma("unroll") for (int k = 0; k < 2; ++k) dst[n][k] = *(const LAS half8*)(lds + PG8_SB(b, h) + boff + n * 2048 + k * 1024); } while (0)
#define PG8_MMA(ai, bj, At, Bt) do { __builtin_amdgcn_s_setprio(1); _Pragma("unroll") for (int m = 0; m < 4; ++m) _Pragma("unroll") for (int n = 0; n < 2; ++n) _Pragma("unroll") for (int k = 0; k < 2; ++k) \
    acc[ai][bj][m][n] = __builtin_amdgcn_mfma_f32_16x16x32_f16(Bt[n][k], At[m][k], acc[ai][bj][m][n], 0, 0, 0); __builtin_amdgcn_s_setprio(0); } while (0)
#define PG8_WAIT_V(n) asm volatile("s_waitcnt vmcnt(" #n ")" ::: "memory")
#define PG8_WAIT_L(n) asm volatile("s_waitcnt lgkmcnt(" #n ")" ::: "memory")
#define PG8_BAR __builtin_amdgcn_s_barrier()
#define PG8_SCHED __builtin_amdgcn_sched_barrier(0)
  Unit cur, nxt; int ui = 0;
  if (!S.next(0, cur)) return;
  f32x4 acc[2][2][4][2];
#pragma unroll
  for (int a = 0; a < 2; ++a)
#pragma unroll
    for (int b = 0; b < 2; ++b)
#pragma unroll
      for (int m = 0; m < 4; ++m)
#pragma unroll
        for (int n = 0; n < 2; ++n) acc[a][b][m][n] = (f32x4){0.f, 0.f, 0.f, 0.f};
  half8 At[4][2], B0[2][2], B1[2][2];
  const char* cA = cur.A; const char* cB = cur.B;
  unsigned vbc[2], vbn[2];
  size_t hBc = (size_t)(cur.pkind == PK_ROPE ? 32 : HALF) * cur.ldb, hBn;
#pragma unroll
  for (int i = 0; i < 2; ++i) { int sR, sC; stage_rc(tid * 16 + i * 8192, sR, sC); vbc[i] = (unsigned)perm_row(sR, cur.pkind) * cur.ldb + (unsigned)sC * 2u; }
  PG8_STAGE(PG8_SB(0, 0), cB, vbc); PG8_STAGE(PG8_SA(0, 0), cA, voffA); PG8_STAGE(PG8_SB(0, 1), cB + hBc, vbc); PG8_STAGE(PG8_SA(0, 1), cA + hstepA, voffA);
  if (wr == 1) PG8_BAR;
  PG8_WAIT_V(4); PG8_BAR;
  PG8_STAGE(PG8_SB(1, 0), cB + kstep, vbc); PG8_STAGE(PG8_SA(1, 0), cA + kstep, voffA); PG8_STAGE(PG8_SB(1, 1), cB + hBc + kstep, vbc);
  PG8_WAIT_V(6); PG8_BAR;
  for (;;) {
    const bool has_next = S.next(ui + 1, nxt);
    const char* nA = has_next ? nxt.A : cA; const char* nB = has_next ? nxt.B : cB;
    hBn = has_next ? (size_t)(nxt.pkind == PK_ROPE ? 32 : HALF) * nxt.ldb : hBc;
#pragma unroll
    for (int i = 0; i < 2; ++i) { int sR, sC; stage_rc(tid * 16 + i * 8192, sR, sC); vbn[i] = has_next ? ((unsigned)perm_row(sR, nxt.pkind) * nxt.ldb + (unsigned)sC * 2u) : vbc[i]; }
    for (int t = 0; t < nt; t += 2) {
      const bool last = (t == nt - 2);
      const char* a1 = cA + (size_t)(t + 1) * kstep;
      const char* a2 = last ? nA : cA + (size_t)(t + 2) * kstep; const char* b2 = last ? nB : cB + (size_t)(t + 2) * kstep;
      const char* a3 = a2 + kstep; const char* b3 = b2 + kstep;
      unsigned vb[2]; vb[0] = last ? vbn[0] : vbc[0]; vb[1] = last ? vbn[1] : vbc[1];
      const size_t hb = last ? hBn : hBc;
      PG8_LDB(B0, 0, 0); PG8_SCHED; PG8_LDA(At, 0, 0); PG8_STAGE(PG8_SA(1, 1), a1 + hstepA, voffA);
      PG8_WAIT_L(8); PG8_BAR; PG8_WAIT_L(0); PG8_MMA(0, 0, At, B0); PG8_BAR; PG8_SCHED;
      PG8_LDB(B1, 0, 1); PG8_STAGE(PG8_SB(0, 0), b2, vb);
      PG8_BAR; PG8_WAIT_L(0); PG8_MMA(0, 1, At, B1); PG8_BAR;
      PG8_LDA(At, 0, 1); PG8_STAGE(PG8_SA(0, 0), a2, voffA);
      PG8_BAR; PG8_WAIT_L(0); PG8_MMA(1, 0, At, B0); PG8_BAR; PG8_SCHED;
      PG8_STAGE(PG8_SB(0, 1), b2 + hb, vb);
      PG8_WAIT_V(6); PG8_BAR; PG8_MMA(1, 1, At, B1); PG8_BAR;
      PG8_LDB(B0, 1, 0); PG8_SCHED; PG8_LDA(At, 1, 0); PG8_STAGE(PG8_SA(0, 1), a2 + hstepA, voffA);
      PG8_WAIT_L(8); PG8_BAR; PG8_WAIT_L(0); PG8_MMA(0, 0, At, B0); PG8_BAR; PG8_SCHED;
      PG8_LDB(B1, 1, 1); PG8_STAGE(PG8_SB(1, 0), b3, vb);
      PG8_BAR; PG8_WAIT_L(0); PG8_MMA(0, 1, At, B1); PG8_BAR;
      PG8_LDA(At, 1, 1); PG8_STAGE(PG8_SA(1, 0), a3, voffA);
      PG8_BAR; PG8_WAIT_L(0); PG8_MMA(1, 0, At, B0); PG8_BAR; PG8_SCHED;
      PG8_STAGE(PG8_SB(1, 1), b3 + hb, vb);
      PG8_WAIT_V(6); PG8_BAR; PG8_MMA(1, 1, At, B1); PG8_BAR;
    }
    E(acc, cur, wr, wc, fr, fq);
    if (!has_next) break;
#pragma unroll
    for (int a = 0; a < 2; ++a)
#pragma unroll
      for (int b = 0; b < 2; ++b)
#pragma unroll
        for (int m = 0; m < 4; ++m)
#pragma unroll
          for (int n = 0; n < 2; ++n) acc[a][b][m][n] = (f32x4){0.f, 0.f, 0.f, 0.f};
    cur = nxt; cA = nA; cB = nB; hBc = hBn; vbc[0] = vbn[0]; vbc[1] = vbn[1]; ++ui;
  }
  PG8_WAIT_V(0);
  if (wr == 0) PG8_BAR;
  PG8_BAR;
#undef PG8_SA
#undef PG8_SB
#undef PG8_STAGE
#undef PG8_LDA
#undef PG8_LDB
#undef PG8_MMA
#undef PG8_WAIT_V
#undef PG8_WAIT_L
#undef PG8_BAR
#undef PG8_SCHED
}
}
typedef f32x4 acc_t[2][2][4][2];


enum { UK_QK = 0, UK_Z = 1, UK_VT = 2 };
struct AttnInSched {
  const char* H; const char* W; int tok0; int S;
  __device__ __forceinline__ bool next(int i, pg8::Unit& u) const {
    const int L = i * ogdim() + obid();
    if (L >= 1280) return false;
    if (L < 896) {
      int pm, pn; pg8::tile_of(L, 32, 28, pm, pn);
      u.pm = pm; u.ldb = 2048u;
      u.A = H + (size_t)(tok0 + pm * 256) * 2048;
      if (pn < 24) {
        const int g = pn >> 3, qk = (pn >> 2) & 1, cb = pn & 3;
        u.kind = UK_QK; u.pkind = pg8::PK_ROPE; u.pn = pn; u.aux = (g * 2 + qk) * 1024 + cb * 256;
        u.B = W + (size_t)(g * 3072 + qk * 1024 + cb * 256) * 2048;
      } else {
        u.kind = UK_Z; u.pkind = pg8::PK_P32; u.pn = pn - 24; u.aux = 0;
        u.B = W + (size_t)(9216 + (pn - 24) * 256) * 2048;
      }
    } else {
      int pm, pn; pg8::tile_of(L - 896, 12, 32, pm, pn);
      const int g = pm >> 2, fb = pm & 3;
      const int d = g == 0 ? 1 : (g == 1 ? 4 : 16);
      const int m = S / d;
      const int tp0 = pn * 256;
      const int sl = tp0 / S, w = tp0 % S, r = w / m, i0 = w % m;
      u.kind = UK_VT; u.pkind = pg8::PK_P32; u.pm = fb; u.pn = pn; u.aux = g;
      u.A = W + (size_t)(g * 3072 + 2048 + fb * 256) * 2048;
      u.B = H + (size_t)(tok0 + sl * S + i0 * d + r) * 2048;
      u.ldb = (unsigned)d * 2048u;
    }
    return true;
  }
};
struct AttnInEpi {
  h16* QK; h16* VT; h16* ZC; const float4* ROPE; int S;
  __device__ __forceinline__ void operator()(const acc_t& acc, const pg8::Unit& u, int wr, int wc, int fr, int fq) const {
    if (u.kind == UK_QK) {
      const float qs = ((u.aux >> 10) & 1) ? 1.f : 0.125f * 1.4426950408889634f;
      const int e0 = 8 * fq;
      const int tl0 = u.pm * 256 + wr * 64 + fr;
      const int ib = (((tl0) & (S - 1)) * 32 + e0) >> 1, ir = (16 * 32 + e0) >> 1;
      float c[8], sn[8], rc[8], rs[8];
#pragma unroll
      for (int k = 0; k < 4; ++k) {
        const float4 bv = ROPE[ib + k], rv = ROPE[ir + k];
        c[2 * k] = bv.x; sn[2 * k] = bv.y; c[2 * k + 1] = bv.z; sn[2 * k + 1] = bv.w;
        rc[2 * k] = rv.x; rs[2 * k] = rv.y; rc[2 * k + 1] = rv.z; rs[2 * k + 1] = rv.w;
      }
#pragma unroll
      for (int ai = 0; ai < 2; ++ai) {
#pragma unroll
        for (int m = 0; m < 4; ++m) {
          const int tl = tl0 + ai * 128 + m * 16;
          half8 o1, o2;
#pragma unroll
          for (int n = 0; n < 2; ++n) {
            const f32x4 t1 = acc[ai][0][m][n], t2 = acc[ai][1][m][n];
#pragma unroll
            for (int j = 0; j < 4; ++j) {
              o1[4 * n + j] = (h16)((t1[j] * c[4 * n + j] - t2[j] * sn[4 * n + j]) * qs);
              o2[4 * n + j] = (h16)((t2[j] * c[4 * n + j] + t1[j] * sn[4 * n + j]) * qs);
            }
          }
          h16* dst = QK + (size_t)tl * 6144 + u.aux + 64 * wc + e0;
          *(half8*)dst = o1;
          *(half8*)(dst + 32) = o2;
          const int nrot = (m < 3) ? 1 : (ai == 0 ? 5 : 0);
#pragma unroll
          for (int k = 0; k < nrot; ++k)
#pragma unroll
            for (int j = 0; j < 8; ++j) { const float cn = c[j] * rc[j] - sn[j] * rs[j], sx = sn[j] * rc[j] + c[j] * rs[j]; c[j] = cn; sn[j] = sx; }
        }
      }
    } else if (u.kind == UK_Z) {
#pragma unroll
      for (int ai = 0; ai < 2; ++ai)
#pragma unroll
        for (int m = 0; m < 4; ++m) {
          const int tl = u.pm * 256 + ai * 128 + wr * 64 + m * 16 + fr;
#pragma unroll
          for (int bj = 0; bj < 2; ++bj) {
            f32x4 a = acc[ai][bj][m][0], b = acc[ai][bj][m][1];
#pragma unroll
            for (int j = 0; j < 4; ++j) { a[j] = silu_f(a[j]); b[j] = silu_f(b[j]); }
            *(half8*)(ZC + (size_t)tl * 1024 + u.pn * 256 + bj * 128 + wc * 32 + 8 * fq) = pack8(a, b);
          }
        }
    } else {
#pragma unroll
      for (int ai = 0; ai < 2; ++ai)
#pragma unroll
        for (int m = 0; m < 4; ++m) {
          const int f = u.pm * 256 + ai * 128 + wr * 64 + m * 16 + fr;
#pragma unroll
          for (int bj = 0; bj < 2; ++bj)
            *(half8*)(VT + ((size_t)u.aux * 1024 + f) * 8192 + u.pn * 256 + bj * 128 + wc * 32 + 8 * fq) = pack8(acc[ai][bj][m][0], acc[ai][bj][m][1]);
        }
    }
  }
};
__device__ __forceinline__ void phase_attn_in(const Params& p, int chunk, char* smem) {
  const int tid = otid();
  AttnInSched S; S.H = p.ws + OFF_R0; S.W = p.ws + OFF_W + WA_IN * 2; S.tok0 = chunk * 8192; S.S = chunk < 2 ? 8192 : 4096;
  AttnInEpi E; E.QK = (h16*)(p.ws + OFF_QK); E.VT = (h16*)(p.ws + OFF_VT); E.ZC = (h16*)(p.ws + OFF_ZC); E.ROPE = (const float4*)(p.ws + OFF_ROPE); E.S = S.S;
  pg8::gemm_phase(( LAS unsigned char*)smem, S, E, tid);
}

struct PlainSched {
  const char* A; const char* W; int nN; int pkind;
  __device__ __forceinline__ bool next(int i, pg8::Unit& u) const {
    const int L = i * ogdim() + obid();
    if (L >= 128 * nN) return false;
    int pm, pn; pg8::tile_of(L, 128, nN, pm, pn);
    u.pm = pm; u.pn = pn; u.ldb = 2048u; u.kind = 0; u.pkind = pkind; u.aux = 0;
    u.A = A + (size_t)pm * 256 * 2048; u.B = W + (size_t)pn * 256 * 2048;
    return true;
  }
};
struct OutEpi {
  const float* xp; const float* xs; const h16* x16in; h16* x16out; const float* ADA; int layer;
  __device__ __forceinline__ void operator()(const acc_t& acc, const pg8::Unit& u, int wr, int wc, int fr, int fq) const {
    const int seq = seq_of_tok(u.pm * 256);
    const float* gate = ADA + (layer * 6 + seq) * 3072 + 2048;
    const int col0 = u.pn * 256 + wc * 32 + 8 * fq;
    f32x4 gv[2][2];
#pragma unroll
    for (int bj = 0; bj < 2; ++bj)
#pragma unroll
      for (int n = 0; n < 2; ++n) gv[bj][n] = *(const f32x4*)(gate + col0 + bj * 128 + 4 * n);
    const int row0 = u.pm * 256 + wr * 64 + fr;
    if (layer == 0) {
      const float* xbase = (row0 < 16384 ? xp : xs - (size_t)16384 * 1024);
      f32x4 xv[2][2], xn[2][2];
#pragma unroll
      for (int bj = 0; bj < 2; ++bj)
#pragma unroll
        for (int n = 0; n < 2; ++n) xv[bj][n] = *(const f32x4*)(xbase + (size_t)row0 * 1024 + col0 + bj * 128 + 4 * n);
#pragma unroll
      for (int k = 0; k < 8; ++k) {
        const int ai = k >> 2, m = k & 3;
        const int row = row0 + ai * 128 + m * 16;
        if (k < 7) {
          const int rn = row0 + ((k + 1) >> 2) * 128 + ((k + 1) & 3) * 16;
#pragma unroll
          for (int bj = 0; bj < 2; ++bj)
#pragma unroll
            for (int n = 0; n < 2; ++n) xn[bj][n] = *(const f32x4*)(xbase + (size_t)rn * 1024 + col0 + bj * 128 + 4 * n);
        }
#pragma unroll
        for (int bj = 0; bj < 2; ++bj)
          *(half8*)(x16out + (size_t)row * 1024 + col0 + bj * 128) = pack8(xv[bj][0] + gv[bj][0] * acc[ai][bj][m][0], xv[bj][1] + gv[bj][1] * acc[ai][bj][m][1]);
#pragma unroll
        for (int bj = 0; bj < 2; ++bj)
#pragma unroll
          for (int n = 0; n < 2; ++n) xv[bj][n] = xn[bj][n];
        asm volatile("" ::: "memory");
      }
    } else {
      half8 xv[2], xn[2];
#pragma unroll
      for (int bj = 0; bj < 2; ++bj) xv[bj] = *(const half8*)(x16in + (size_t)row0 * 1024 + col0 + bj * 128);
#pragma unroll
      for (int k = 0; k < 8; ++k) {
        const int ai = k >> 2, m = k & 3;
        const int row = row0 + ai * 128 + m * 16;
        if (k < 7) {
          const int rn = row0 + ((k + 1) >> 2) * 128 + ((k + 1) & 3) * 16;
#pragma unroll
          for (int bj = 0; bj < 2; ++bj) xn[bj] = *(const half8*)(x16in + (size_t)rn * 1024 + col0 + bj * 128);
        }
#pragma unroll
        for (int bj = 0; bj < 2; ++bj) {
          f32x4 lo, hi;
#pragma unroll
          for (int j = 0; j < 4; ++j) { lo[j] = (float)xv[bj][j]; hi[j] = (float)xv[bj][4 + j]; }
          *(half8*)(x16out + (size_t)row * 1024 + col0 + bj * 128) = pack8(lo + gv[bj][0] * acc[ai][bj][m][0], hi + gv[bj][1] * acc[ai][bj][m][1]);
        }
#pragma unroll
        for (int bj = 0; bj < 2; ++bj) xv[bj] = xn[bj];
        asm volatile("" ::: "memory");
      }
    }
  }
};
__device__ __forceinline__ void phase_out_gemm(const Params& p, int layer, const char* A, const char* Wt, char* smem) {
  const int tid = otid();
  PlainSched S; S.A = A; S.W = Wt; S.nN = 4; S.pkind = pg8::PK_P32;
  OutEpi E; E.xp = p.x_prompt; E.xs = p.x_sample; E.x16in = (const h16*)p.out; E.x16out = (layer == 3) ? (h16*)(p.ws + OFF_R3) : (h16*)p.out;
  E.ADA = (const float*)(p.ws + OFF_ADA); E.layer = layer;
  pg8::gemm_phase((LAS unsigned char*)smem, S, E, tid);
}

struct SsmInEpi {
  h16* U; h16* Z;
  __device__ __forceinline__ void operator()(const acc_t& acc, const pg8::Unit& u, int wr, int wc, int fr, int fq) const {
    const bool isz = u.pn >= 4;
    h16* dstb = (isz ? Z : U) + (u.pn & 3) * 256 + wc * 32 + 8 * fq;
#pragma unroll
    for (int ai = 0; ai < 2; ++ai)
#pragma unroll
      for (int m = 0; m < 4; ++m) {
        const int row = u.pm * 256 + ai * 128 + wr * 64 + m * 16 + fr;
#pragma unroll
        for (int bj = 0; bj < 2; ++bj) {
          f32x4 a = acc[ai][bj][m][0], b = acc[ai][bj][m][1];
          if (isz) {
#pragma unroll
            for (int j = 0; j < 4; ++j) { a[j] = silu_f(a[j]); b[j] = silu_f(b[j]); }
          }
          *(half8*)(dstb + (size_t)row * 1024 + bj * 128) = pack8(a, b);
        }
      }
  }
};
__device__ __forceinline__ void phase_ssm_in(const Params& p, char* smem) {
  const int tid = otid();
  PlainSched S; S.A = p.ws + OFF_R0; S.W = p.ws + OFF_W + WS_IN * 2; S.nN = 8; S.pkind = pg8::PK_P32;
  SsmInEpi E; E.U = (h16*)(p.ws + OFF_R1); E.Z = (h16*)(p.ws + OFF_R2);
  pg8::gemm_phase((LAS unsigned char*)smem, S, E, tid);
}

struct GluEpi {
  const h16* G; const h16* Z; h16* Y2;
  __device__ __forceinline__ void operator()(const acc_t& acc, const pg8::Unit& u, int wr, int wc, int fr, int fq) const {
    const size_t o0 = (size_t)(u.pm * 256 + wr * 64 + fr) * 1024 + u.pn * 256 + wc * 32 + 8 * fq;
    half8 gv[2], zv[2], gn[2], zn[2];
#pragma unroll
    for (int bj = 0; bj < 2; ++bj) { gv[bj] = *(const half8*)(G + o0 + bj * 128); zv[bj] = *(const half8*)(Z + o0 + bj * 128); }
#pragma unroll
    for (int ai = 0; ai < 2; ++ai)
#pragma unroll
      for (int m = 0; m < 4; ++m) {
        const size_t orow = o0 + (size_t)(ai * 128 + m * 16) * 1024;
        if (ai * 4 + m < 7) {
          const size_t onx = o0 + (size_t)(((ai * 4 + m + 1) >> 2) * 128 + ((ai * 4 + m + 1) & 3) * 16) * 1024;
#pragma unroll
          for (int bj = 0; bj < 2; ++bj) { gn[bj] = *(const half8*)(G + onx + bj * 128); zn[bj] = *(const half8*)(Z + onx + bj * 128); }
        }
#pragma unroll
        for (int bj = 0; bj < 2; ++bj) {
          const f32x4 a = acc[ai][bj][m][0], b = acc[ai][bj][m][1];
          half8 r;
#pragma unroll
          for (int j = 0; j < 4; ++j) {
            r[j] = (h16)((float)gv[bj][j] * sigmoid_f(a[j]) * (float)zv[bj][j]);
            r[4 + j] = (h16)((float)gv[bj][4 + j] * sigmoid_f(b[j]) * (float)zv[bj][4 + j]);
          }
          *(half8*)(Y2 + orow + bj * 128) = r;
        }
#pragma unroll
        for (int bj = 0; bj < 2; ++bj) { gv[bj] = gn[bj]; zv[bj] = zn[bj]; }
        asm volatile("" ::: "memory");
      }
  }
};
__device__ __forceinline__ void phase_ssm_glu(const Params& p, char* smem) {
  const int tid = otid();
  PlainSched S; S.A = p.ws + OFF_R0; S.W = p.ws + OFF_W + WS_GLU * 2; S.nN = 4; S.pkind = pg8::PK_P32;
  GluEpi E; E.G = (const h16*)(p.ws + OFF_R0); E.Z = (const h16*)(p.ws + OFF_R2); E.Y2 = (h16*)(p.ws + OFF_R1);
  pg8::gemm_phase((LAS unsigned char*)smem, S, E, tid);
}

__device__ __forceinline__ void sub_barrier(volatile LAS unsigned* cnt, unsigned& target, int lane) {
  asm volatile("s_waitcnt vmcnt(0) lgkmcnt(0)" ::: "memory");
  if (lane == 0) {
    __hip_atomic_fetch_add((LAS unsigned*)cnt, 1u, __ATOMIC_RELAXED, __HIP_MEMORY_SCOPE_WORKGROUP);
    while (__hip_atomic_load((LAS unsigned*)cnt, __ATOMIC_RELAXED, __HIP_MEMORY_SCOPE_WORKGROUP) < target) __builtin_amdgcn_s_sleep(1);
  }
  target += 4u;
  asm volatile("" ::: "memory");
}
__device__ __forceinline__ void phase_attn(const Params& p, int chunk, char* smem) {
  const int tid0 = otid(), lane = tid0 & 63, wave8 = tid0 >> 6;
  const int sub = wave8 >> 2, wave = wave8 & 3, tid = tid0 & 255;
  const h16* QK = (const h16*)(p.ws + OFF_QK);
  const h16* VT = (const h16*)(p.ws + OFF_VT);
  h16* O3 = (h16*)(p.ws + OFF_O3);
  float* LSE = (float*)(p.ws + OFF_LSE);
  const int S = chunk < 2 ? 8192 : 4096;
  constexpr int KROW = 72, VROW = 264;
  h16* Ks = (h16*)(smem + sub * ATT_LDS);
  h16* Vs = (h16*)(smem + sub * ATT_LDS + 256 * KROW * 2);
  volatile LAS unsigned* cnt = (volatile LAS unsigned*)(smem + 2 * ATT_LDS) + sub * 32;
  if (tid0 < 64) ((volatile LAS unsigned*)(smem + 2 * ATT_LDS))[tid0] = 0u;
  __syncthreads();
  unsigned target = 4u;
  const int n = lane & 31, hh = lane >> 5;
  const int qw = wave * 32;
  const int NIT = 3 * 64 * 8;
  auto decode = [&](int it0, int& hd, int& g, int& d, int& m, int& sl, int& r, int& i0) {
    const int it = it0 * 2 + sub;
    hd = it & 15; const int rest = it >> 4;
    g = rest / 64; const int blk = rest % 64;
    d = g == 0 ? 1 : (g == 1 ? 4 : 16);
    m = S / d;
    const int tp0 = blk * 128;
    sl = tp0 / S; const int w = tp0 % S; r = w / m; i0 = w % m;
  };
  half8 kreg[8], vreg[8], qpre[4];
  auto load_kq = [&](int it0) {
    int hd, g, d, m, sl, r, i0; decode(it0, hd, g, d, m, sl, r, i0);
#pragma unroll
    for (int itx = 0; itx < 8; ++itx) {
      const int idx = tid + 256 * itx;
      const int row = idx >> 3, ch = idx & 7;
      const int kj = i0 - 64 + row;
      half8 v = zero8();
      if (kj >= 0 && kj < m) v = *(const half8*)(QK + (size_t)(sl * S + kj * d + r) * 6144 + (g * 2 + 1) * 1024 + hd * 64 + ch * 8);
      kreg[itx] = v;
    }
  };
  auto load_v = [&](int it0) {
    int hd, g, d, m, sl, r, i0; decode(it0, hd, g, d, m, sl, r, i0);
    const h16* qp = QK + (size_t)(sl * S + (i0 + qw + n) * d + r) * 6144 + (g * 2) * 1024 + hd * 64 + hh * 8;
#pragma unroll
    for (int ks = 0; ks < 4; ++ks) qpre[ks] = *(const half8*)(qp + ks * 16);
#pragma unroll
    for (int itx = 0; itx < 8; ++itx) {
      const int idx = tid + 256 * itx;
      const int row = idx >> 5, ch = idx & 31;
      const int kj = i0 - 64 + ch * 8;
      half8 v = zero8();
      if (kj >= 0 && kj < m) v = *(const half8*)(VT + ((size_t)g * 1024 + hd * 64 + row) * 8192 + sl * S + r * m + kj);
      vreg[itx] = v;
    }
  };
  int it0 = obid();
  if (it0 < NIT) { load_kq(it0); load_v(it0); }
  for (; it0 < NIT; it0 += ogdim()) {
    int hd, g, d, m, sl, r, i0; decode(it0, hd, g, d, m, sl, r, i0);
    const int itn = it0 + ogdim();
#pragma unroll
    for (int itx = 0; itx < 8; ++itx) { const int idx = tid + 256 * itx; *(half8*)(Ks + (idx >> 3) * KROW + (idx & 7) * 8) = kreg[itx]; }
#pragma unroll
    for (int itx = 0; itx < 8; ++itx) { const int idx = tid + 256 * itx; *(half8*)(Vs + (idx >> 5) * VROW + (idx & 31) * 8) = vreg[itx]; }
    sub_barrier(cnt, target, lane);
    if (itn < NIT) load_kq(itn);
    f32x16 sc[5];
#pragma unroll
    for (int kb = 0; kb < 5; ++kb) {
#pragma unroll
      for (int i = 0; i < 16; ++i) sc[kb][i] = 0.f;
#pragma unroll
      for (int ks = 0; ks < 4; ++ks) {
        half8 kf = *(const half8*)(Ks + (qw + kb * 32 + n) * KROW + ks * 16 + hh * 8);
        sc[kb] = MFMA32(kf, qpre[ks], sc[kb]);
      }
      __builtin_amdgcn_sched_barrier(0);
    }
    if (itn < NIT) load_v(itn);
    const int qi = i0 + qw + n;
    const bool edge = (i0 + qw < 64) || (i0 + qw + 96 > m);
    if (edge) {
      const int lo = max(qi - 64, 0), hi = min(qi + 64, m - 1);
#pragma unroll
      for (int kb = 0; kb < 5; ++kb)
#pragma unroll
        for (int i = 0; i < 16; ++i) {
          int kj = i0 + qw - 64 + kb * 32 + 8 * (i >> 2) + 4 * hh + (i & 3);
          sc[kb][i] = (kj >= lo && kj <= hi) ? sc[kb][i] : -1e30f;
        }
    } else {
      const int nn0 = n - 4 * hh;
#pragma unroll
      for (int i = 0; i < 16; ++i) {
        const int ci = 8 * (i >> 2) + (i & 3);
        sc[0][i] = (ci >= nn0) ? sc[0][i] : -1e30f;
        sc[4][i] = (ci <= nn0) ? sc[4][i] : -1e30f;
      }
    }
    float mx = -1e30f;
#pragma unroll
    for (int kb = 0; kb < 5; ++kb)
#pragma unroll
      for (int i = 0; i < 16; ++i) mx = fmaxf(mx, sc[kb][i]);
    mx = fmaxf(mx, shx(mx, 32, lane));
    float sum = 0.f;
    half8 pfa[5][2];
#pragma unroll
    for (int kb = 0; kb < 5; ++kb)
#pragma unroll
      for (int i = 0; i < 16; ++i) {
        float pv = __builtin_amdgcn_exp2f(sc[kb][i] - mx);
        pfa[kb][i >> 3][i & 7] = (h16)pv;
        sum += pv;
      }
    sum += shx(sum, 32, lane);
    asm volatile("" : "+v"(pfa[0][0]), "+v"(pfa[0][1]), "+v"(pfa[1][0]), "+v"(pfa[1][1]), "+v"(pfa[2][0]), "+v"(pfa[2][1]), "+v"(pfa[3][0]), "+v"(pfa[3][1]), "+v"(pfa[4][0]), "+v"(pfa[4][1]));
    f32x16 oacc[2];
#pragma unroll
    for (int mb = 0; mb < 2; ++mb)
#pragma unroll
      for (int i = 0; i < 16; ++i) oacc[mb][i] = 0.f;
#pragma unroll
    for (int kb = 0; kb < 5; ++kb)
#pragma unroll
      for (int s2 = 0; s2 < 2; ++s2) {
        const half8 pf = pfa[kb][s2];
#pragma unroll
        for (int mb = 0; mb < 2; ++mb) {
          const h16* vp = Vs + (mb * 32 + n) * VROW + qw + kb * 32 + 16 * s2 + 4 * hh;
          half4 v0 = *(const half4*)(vp), v1 = *(const half4*)(vp + 8);
          half8 vf = {v0[0], v0[1], v0[2], v0[3], v1[0], v1[1], v1[2], v1[3]};
          oacc[mb] = MFMA32(vf, pf, oacc[mb]);
        }
        __builtin_amdgcn_sched_barrier(0);
      }
    float inv = 1.f / sum;
    int tl = sl * S + qi * d + r;
    h16* op = O3 + ((size_t)g * 8192 + tl) * 1024 + hd * 64;
#pragma unroll
    for (int mb = 0; mb < 2; ++mb)
#pragma unroll
      for (int pq = 0; pq < 2; ++pq) {
        union { half4 h; int w[2]; } he, ho, rv;
#pragma unroll
        for (int rr = 0; rr < 4; ++rr) { he.h[rr] = (h16)(oacc[mb][8 * pq + rr] * inv); ho.h[rr] = (h16)(oacc[mb][8 * pq + 4 + rr] * inv); }
        const int s0 = hh ? he.w[0] : ho.w[0], s1 = hh ? he.w[1] : ho.w[1];
        rv.w[0] = __builtin_amdgcn_ds_bpermute((lane ^ 32) << 2, s0);
        rv.w[1] = __builtin_amdgcn_ds_bpermute((lane ^ 32) << 2, s1);
        const half4 lo = hh ? rv.h : he.h, hi = hh ? ho.h : rv.h;
        const half8 o = {lo[0], lo[1], lo[2], lo[3], hi[0], hi[1], hi[2], hi[3]};
        *(half8*)(op + mb * 32 + 8 * (2 * pq + hh)) = o;
      }
    if (hh == 0) LSE[((size_t)g * 8192 + tl) * 16 + hd] = (mx + __builtin_amdgcn_logf(sum)) * 0.6931471805599453f;
    sub_barrier(cnt, target, lane);
  }
  __syncthreads();
}

__device__ __forceinline__ void phase_attn_combine(const Params& p, int chunk) {
  const h16* O3 = (const h16*)(p.ws + OFF_O3);
  const float* LSE = (const float*)(p.ws + OFF_LSE);
  const h16* ZC = (const h16*)(p.ws + OFF_ZC);
  h16* YA = (h16*)(p.ws + OFF_R0) + (size_t)chunk * 8192 * 1024;
  for (int it = obid(); it < 8192 * 128 / NT; it += ogdim()) {
    int idx = it * NT + otid();
    int tl = idx >> 7, c8 = idx & 127;
    int hd = c8 >> 3;
    float l0 = LSE[((size_t)0 * 8192 + tl) * 16 + hd], l1 = LSE[((size_t)1 * 8192 + tl) * 16 + hd], l2 = LSE[((size_t)2 * 8192 + tl) * 16 + hd];
    float mx = fmaxf(l0, fmaxf(l1, l2));
    float w0 = __expf(l0 - mx), w1 = __expf(l1 - mx), w2 = __expf(l2 - mx);
    float inv = __builtin_amdgcn_rcpf(w0 + w1 + w2);
    w0 *= inv; w1 *= inv; w2 *= inv;
    size_t off = (size_t)tl * 1024 + c8 * 8;
    half8 a = *(const half8*)(O3 + off), b = *(const half8*)(O3 + (size_t)8192 * 1024 + off), c = *(const half8*)(O3 + (size_t)2 * 8192 * 1024 + off);
    half8 z = *(const half8*)(ZC + off);
    half8 o;
#pragma unroll
    for (int j = 0; j < 8; ++j) o[j] = (h16)((w0 * (float)a[j] + w1 * (float)b[j] + w2 * (float)c[j]) * (float)z[j]);
    *(half8*)(YA + off) = o;
  }
}

struct ScanPar { float lbr[2], lbi[2], nlbi[2], dt; half8 Bop[4]; half8 Cop[4]; };
__device__ __forceinline__ void scan_setup(const Params& p, int j, int dir, int g, int lane, bool needC, ScanPar& P) {
  const int n = lane & 31, hh = lane >> 5;
  const size_t pbase = (((size_t)j * 2 + dir) * 64 + g);
  const float dt = __expf(p.log_dt[pbase]);
  P.dt = dt;
  float fr[2], fi[2];
#pragma unroll
  for (int s = 0; s < 2; ++s) {
    int st = n + 32 * s;
    float lre = fminf(p.lam_re[pbase * 64 + st], -1e-4f);
    float lim = p.lam_im[pbase * 64 + st];
    float zr = lre * dt, zi = lim * dt;
    float er = __expf(zr);
    float sn, cs, snh, csh;
    sincos_acc(zi, sn, cs);
    sincos_acc(0.5f * zi, snh, csh);
    P.lbr[s] = er * cs;
    P.lbi[s] = er * sn;
    P.nlbi[s] = -P.lbi[s];
    float nr = expm1f(zr) * cs - 2.f * snh * snh, ni = er * sn;
    float den = 1.f / (zr * zr + zi * zi);
    fr[s] = (nr * zr + ni * zi) * den;
    fi[s] = (ni * zr - nr * zi) * den;
  }
#pragma unroll
  for (int s = 0; s < 2; ++s) {
    int st = n + 32 * s;
    const float* br = p.b_re + (pbase * 64 + st) * 16 + 8 * hh;
    const float* bi = p.b_im + (pbase * 64 + st) * 16 + 8 * hh;
#pragma unroll
    for (int jj = 0; jj < 8; ++jj) {
      float a = br[jj], b = bi[jj];
      P.Bop[2 * s][jj] = (h16)(fr[s] * a - fi[s] * b);
      P.Bop[2 * s + 1][jj] = (h16)(fr[s] * b + fi[s] * a);
    }
  }
  if (needC) {
    int ch = lane & 15, qd = lane >> 4;
#pragma unroll
    for (int kb = 0; kb < 4; ++kb)
#pragma unroll
      for (int jj = 0; jj < 8; ++jj) {
        int kap = 32 * kb + 8 * qd + jj;
        int np = kap >> 2, which = kap & 3;
        int st = np + 32 * (which >> 1);
        size_t ci = (pbase * 16 + ch) * 64 + st;
        P.Cop[kb][jj] = (which & 1) ? (h16)(-p.c_im[ci]) : (h16)(p.c_re[ci]);
      }
  }
}
template <int MODE>
__device__ __forceinline__ void scan_run(const Params& p, const ScanPar& P, const int dir, const int g, const int sp, const int lane, h16* X, const f32x4 dsk) {
  const int n = lane & 31, hh = lane >> 5;
  const h16* U = (const h16*)(p.ws + OFF_R1);
  h16* Y = (h16*)(p.ws + OFF_R0);
  float4* ENDS = (float4*)(p.ws + OFF_ENDS);
  constexpr int XROW = 136;
  const int pairtok = sp * 512;
  const int S = pairtok < 16384 ? 8192 : 4096;
  const int seqstart = pairtok < 16384 ? (pairtok & ~8191) : 16384 + ((pairtok - 16384) & ~4095);
  const int segt = ((pairtok - seqstart) >> 8) + hh;
  const int nseg = S >> 8;
  const int segstart = seqstart + segt * 256;
  const int gseg0 = seqstart >> 8;
  float xr0 = 0.f, xi0 = 0.f, xr1 = 0.f, xi1 = 0.f;
  if (MODE != 0) {
    float pr0 = P.lbr[0], pi0 = P.lbi[0], pr1 = P.lbr[1], pi1 = P.lbi[1];
#pragma unroll
    for (int q = 0; q < 8; ++q) {
      float a = pr0 * pr0 - pi0 * pi0, b = 2.f * pr0 * pi0; pr0 = a; pi0 = b;
      float c = pr1 * pr1 - pi1 * pi1, dd = 2.f * pr1 * pi1; pr1 = c; pi1 = dd;
    }
    const float4* eb = ENDS + ((size_t)(dir * 64 + g) * 128) * 32;
    int cnt = dir == 0 ? segt : (nseg - 1 - segt);
    for (int c = 0; c < cnt; ++c) {
      int sg = dir == 0 ? c : (nseg - 1 - c);
      float4 e = eb[(size_t)(gseg0 + sg) * 32 + n];
      float a = pr0 * xr0 - pi0 * xi0 + e.x, b = pr0 * xi0 + pi0 * xr0 + e.y;
      xr0 = a; xi0 = b;
      float c2 = pr1 * xr1 - pi1 * xi1 + e.z, d2 = pr1 * xi1 + pi1 * xr1 + e.w;
      xr1 = c2; xi1 = d2;
    }
  }
  const int am = lane & 31;
  const int ahalf = (am >> 2) & 1, astep = ((am >> 3) << 2) | (am & 3);
  const int asegstart = seqstart + (((pairtok - seqstart) >> 8) + ahalf) * 256;
  const h16* ubase = U + g * 16 + 8 * (lane >> 5);
  auto utok = [&](int ci) { int tau = ci * 16 + astep; return dir ? (asegstart + 255 - tau) : (asegstart + tau); };
  half8 unext = *(const half8*)(ubase + (size_t)utok(0) * 1024);
  for (int ci = 0; ci < 16; ++ci) {
    half8 ua = unext;
    if (ci + 1 < 16) unext = *(const half8*)(ubase + (size_t)utok(ci + 1) * 1024);
    const int trow = lane & 15, qd = lane >> 4;
    half4 uo[2]; unsigned yp[2][2];
    if (MODE == 2) {
#pragma unroll
      for (int h2 = 0; h2 < 2; ++h2) {
        int sst = seqstart + (((pairtok - seqstart) >> 8) + h2) * 256;
        int tau = ci * 16 + trow;
        int tok = dir ? (sst + 255 - tau) : (sst + tau);
        const size_t off = (size_t)tok * 1024 + g * 16 + 4 * qd;
        uo[h2] = *(const half4*)(U + off);
        yp[h2][0] = __hip_atomic_load((unsigned*)(Y + off), __ATOMIC_RELAXED, __HIP_MEMORY_SCOPE_AGENT);
        yp[h2][1] = __hip_atomic_load((unsigned*)(Y + off) + 1, __ATOMIC_RELAXED, __HIP_MEMORY_SCOPE_AGENT);
      }
    }
    f32x16 bu[4];
#pragma unroll
    for (int nb = 0; nb < 4; ++nb) {
      f32x16 z;
#pragma unroll
      for (int i = 0; i < 16; ++i) z[i] = 0.f;
      bu[nb] = MFMA32(ua, P.Bop[nb], z);
    }
#pragma unroll
    for (int i = 0; i < 16; ++i) {
      float a = afma(P.lbr[0], xr0, afma(P.nlbi[0], xi0, bu[0][i]));
      float b = afma(P.lbr[0], xi0, afma(P.lbi[0], xr0, bu[1][i]));
      xr0 = a; xi0 = b;
      float c = afma(P.lbr[1], xr1, afma(P.nlbi[1], xi1, bu[2][i]));
      float dd = afma(P.lbr[1], xi1, afma(P.lbi[1], xr1, bu[3][i]));
      xr1 = c; xi1 = dd;
      asm volatile("" : "+v"(xr0), "+v"(xi0), "+v"(xr1), "+v"(xi1));
      if (MODE != 0) {
        half4 hv = {(h16)xr0, (h16)xi0, (h16)xr1, (h16)xi1};
        *(half4*)(X + (hh * 16 + i) * XROW + 4 * n) = hv;
      }
    }
    if (MODE != 0) {
      asm volatile("s_waitcnt lgkmcnt(0)" ::: "memory");
#pragma unroll
      for (int h2 = 0; h2 < 2; ++h2) {
        f32x4 y = {0.f, 0.f, 0.f, 0.f};
#pragma unroll
        for (int kb = 0; kb < 4; ++kb) {
          half8 xb = *(const half8*)(X + (h2 * 16 + trow) * XROW + 32 * kb + 8 * qd);
          y = MFMA16(P.Cop[kb], xb, y);
        }
        int sst = seqstart + (((pairtok - seqstart) >> 8) + h2) * 256;
        int tau = ci * 16 + trow;
        int tok = dir ? (sst + 255 - tau) : (sst + tau);
        h16* dst = Y + (size_t)tok * 1024 + g * 16 + 4 * qd;
        if (MODE == 1) {
          half4 o = {(h16)(y[0] * P.dt), (h16)(y[1] * P.dt), (h16)(y[2] * P.dt), (h16)(y[3] * P.dt)};
          *(half4*)dst = o;
        } else {
          union { unsigned w[2]; half4 h; } cv; cv.w[0] = yp[h2][0]; cv.w[1] = yp[h2][1];
          half4 o;
#pragma unroll
          for (int k = 0; k < 4; ++k) o[k] = (h16)gelu_tanh(dsk[k] * (float)uo[h2][k] + (float)cv.h[k] + y[k] * P.dt);
          *(half4*)dst = o;
        }
      }
      asm volatile("s_waitcnt lgkmcnt(0)" ::: "memory");
    }
  }
  if (MODE == 0) ENDS[((size_t)(dir * 64 + g) * 128 + (segstart >> 8)) * 32 + n] = make_float4(xr0, xi0, xr1, xi1);
}
__device__ __forceinline__ void phase_scan1(const Params& p, int j, char* smem) {
  const int tid = otid(), lane = tid & 63, wave = tid >> 6;
  const int nwaves = ogdim() * 8;
  const int wpc = nwaves >> 7;
  const int wglob = obid() * 8 + wave;
  if (wglob < wpc * 128) {
    const int combo = wglob & 127, slot = wglob >> 7;
    const int dir = combo & 1, g = combo >> 1;
    ScanPar P; scan_setup(p, j, dir, g, lane, false, P);
    const f32x4 dz = {0.f, 0.f, 0.f, 0.f};
    for (int sp = slot; sp < 64; sp += wpc) scan_run<0>(p, P, dir, g, sp, lane, (h16*)smem, dz);
  }
}
__device__ __forceinline__ void phase_scan2(const Params& p, int j, char* smem) {
  const int tid = otid(), lane = tid & 63, wave = tid >> 6;
  h16* X = (h16*)smem + wave * 32 * 136;
  const int nwaves = ogdim() * 8;
  const int wpg = nwaves >> 6;
  const int wglob = obid() * 8 + wave;
  if (wglob < wpg * 64) {
    const int g = wglob & 63, slot = wglob >> 6;
    ScanPar P0, P1;
    scan_setup(p, j, 0, g, lane, true, P0);
    scan_setup(p, j, 1, g, lane, true, P1);
    const f32x4 dsk = *(const f32x4*)(p.ssm_d + j * 1024 + g * 16 + 4 * (lane >> 4));
    for (int sp = slot; sp < 64; sp += wpg) {
      scan_run<1>(p, P0, 0, g, sp, lane, X, dsk);
      asm volatile("s_waitcnt vmcnt(0)" ::: "memory");
      scan_run<2>(p, P1, 1, g, sp, lane, X, dsk);
    }
  }
}

#define XB_TMO      128
#define XB_XCNT(j)  (256  + 64 * (j))
#define XB_XSUB(j)  (1280 + 64 * (j))
#define XB_XGEN(j)  (2304 + 64 * (j))
#define XB_TOP      3328
#define XB_TOPGEN   3392
#define XCD_BAR_WORDS 3456
#define XB_SPIN_CAP (1u << 22)
__device__ __forceinline__ unsigned xb_ld(unsigned* p)              { return __hip_atomic_load(p, __ATOMIC_RELAXED, __HIP_MEMORY_SCOPE_AGENT); }
__device__ __forceinline__ unsigned xb_add(unsigned* p, unsigned v) { return __hip_atomic_fetch_add(p, v, __ATOMIC_RELAXED, __HIP_MEMORY_SCOPE_AGENT); }
__device__ __forceinline__ unsigned xb_xcc_id() { return (unsigned)__builtin_amdgcn_s_getreg((3 << 11) | 20) & 0xFu; }
#define XB_SPIN(cond, bar) do { unsigned _sp = 0; while (cond) { __builtin_amdgcn_s_sleep(1); \
    if ((++_sp & 255u) == 0u) { if (xb_ld(&(bar)[XB_TMO])) break; if (_sp > XB_SPIN_CAP) { atomicAdd(&(bar)[XB_TMO], 1u); break; } } } } while (0)
struct XcdBarrier { unsigned* bar; unsigned x; volatile LAS unsigned* st; };
__device__ __forceinline__ XcdBarrier xcd_barrier_post(unsigned* bar, volatile LAS unsigned* st) {
  XcdBarrier b; b.bar = bar; b.x = xb_xcc_id(); b.st = st;
  if (threadIdx.x == 0) (void)xb_add(&bar[XB_XCNT(b.x)], 1u);
  return b;
}
__device__ __forceinline__ void xcd_barrier_complete(unsigned* bar, unsigned x, unsigned& nloc, unsigned& nx) {
  const unsigned G = gridDim.x * gridDim.y * gridDim.z;
  unsigned sum, cnt, mine, sp = 0u;
  for (;;) {
    sum = 0u; cnt = 0u; mine = 0u;
#pragma unroll
    for (unsigned j = 0; j < 16; ++j) { const unsigned c = xb_ld(&bar[XB_XCNT(j)]); sum += c; cnt += (c > 0u) ? 1u : 0u; mine = (j == x) ? c : mine; }
    if (sum == G) break;
    __builtin_amdgcn_s_sleep(1);
    if ((++sp & 255u) == 0u) { if (xb_ld(&bar[XB_TMO])) break; if (sp > XB_SPIN_CAP) { atomicAdd(&bar[XB_TMO], 1u); break; } }
  }
  nloc = mine > 0u ? mine : 1u; nx = cnt > 0u ? cnt : 1u;
}
__device__ __forceinline__ void xcd_barrier(const XcdBarrier& b) {
  asm volatile("s_waitcnt vmcnt(0)" ::: "memory");
  __syncthreads();
  if (threadIdx.x == 0) {
    unsigned* bar = b.bar;
    __builtin_amdgcn_s_waitcnt(0);
    unsigned nloc = b.st[0], nx = b.st[1];
    if (nloc == 0u) { xcd_barrier_complete(bar, b.x, nloc, nx); b.st[0] = nloc; b.st[1] = nx; }
    const unsigned old = xb_add(&bar[XB_XSUB(b.x)], 1u);
    const unsigned gen = old / nloc;
    if (old + 1u == (gen + 1u) * nloc) {
      __builtin_amdgcn_fence(__ATOMIC_RELEASE, "agent");
      asm volatile("s_waitcnt vmcnt(0)" ::: "memory");
      const unsigned og = xb_add(&bar[XB_TOP], 1u);
      const unsigned tg = og / nx;
      if (og + 1u == (tg + 1u) * nx) xb_add(&bar[XB_TOPGEN], 1u);
      else XB_SPIN(xb_ld(&bar[XB_TOPGEN]) == tg, bar);
      __builtin_amdgcn_fence(__ATOMIC_ACQUIRE, "agent");
      xb_add(&bar[XB_XGEN(b.x)], 1u);
      asm volatile("s_waitcnt vmcnt(0)" ::: "memory");
    } else {
      XB_SPIN(xb_ld(&bar[XB_XGEN(b.x)]) == gen, bar);
      __builtin_amdgcn_fence(__ATOMIC_ACQUIRE, "agent");
      asm volatile("s_waitcnt vmcnt(0)" ::: "memory");
    }
  }
  __syncthreads();
}

#ifndef PROBE_DUP
#define PROBE_DUP 0
#endif
#define SYNC() do { XcdBarrier xb_; xb_.bar = (unsigned*)(p.ws + OFF_BAR); xb_.x = xb_xcc_id(); xb_.st = (volatile LAS unsigned*)(smem + 147456); xcd_barrier(xb_); } while (0)
__global__ void __launch_bounds__(NT, 2) mega(Params p) {
  extern __shared__ __attribute__((aligned(16))) char smem[];
  if (threadIdx.x == 0) *(uint4*)(smem + 147456) = make_uint4(0u, 0u, 0u, 0u);
  __syncthreads();
  (void)xcd_barrier_post((unsigned*)(p.ws + OFF_BAR), (volatile LAS unsigned*)(smem + 147456));
  phase0(p, smem);
  cg::this_grid().sync();
  for (int layer = 0; layer < 4; ++layer) {
    phase_norm(p, layer, smem);
    SYNC();
    if (PROBE_DUP & 32) { phase_norm(p, layer, smem); SYNC(); }
    if ((layer & 1) == 0) {
      for (int chunk = 0; chunk < 4; ++chunk) {
        phase_attn_in(p, chunk, smem);
        SYNC();
        if (PROBE_DUP & 16) { phase_attn_in(p, chunk, smem); SYNC(); }
        phase_attn(p, chunk, smem);
        SYNC();
        if (PROBE_DUP & 1) { phase_attn(p, chunk, smem); SYNC(); }
        phase_attn_combine(p, chunk);
        SYNC();
        if (PROBE_DUP & 64) { phase_attn_combine(p, chunk); SYNC(); }
      }
      phase_out_gemm(p, layer, p.ws + OFF_R0, p.ws + OFF_W + WA_OUT * 2, smem);
      SYNC();
    } else {
      int j = layer >> 1;
      phase_ssm_in(p, smem);
      SYNC();
      phase_scan1(p, j, smem);
      SYNC();
      phase_scan2(p, j, smem);
      SYNC();
      phase_ssm_glu(p, smem);
      SYNC();
      if (PROBE_DUP & 128) { phase_ssm_glu(p, smem); SYNC(); }
      phase_out_gemm(p, layer, p.ws + OFF_R1, p.ws + OFF_W + WS_OUT * 2, smem);
      SYNC();
    }
  }
  phase_final_norm(p);
}

extern "C" void kernel_launch(void* const* d_in, const int* in_sizes, int n_in, void* d_out, int out_size,
                              void* d_ws, size_t ws_size, hipStream_t stream) {
  static int grid_blocks = 0;
  if (!grid_blocks) {
    int dev = 0, cus = 0, per_cu = 0;
    hipGetDevice(&dev);
    hipDeviceGetAttribute(&cus, hipDeviceAttributeMultiprocessorCount, dev);
    hipFuncSetAttribute((const void*)mega, hipFuncAttributeMaxDynamicSharedMemorySize, SMEM_BYTES);
    hipOccupancyMaxActiveBlocksPerMultiprocessor(&per_cu, mega, NT, SMEM_BYTES);
    (void)hipGetLastError();
    grid_blocks = cus;
  }
  Params p{};
  p.x_prompt = (const float*)d_in[0]; p.x_sample = (const float*)d_in[1];
  p.c_prompt = (const float*)d_in[2]; p.c_sample = (const float*)d_in[3];
  p.norm_g = (const float*)d_in[4]; p.ada_w = (const float*)d_in[5]; p.ada_b = (const float*)d_in[6];
  p.attn_w_in = (const float*)d_in[7]; p.attn_w_out = (const float*)d_in[8]; p.ssm_w_in = (const float*)d_in[9];
  p.lam_re = (const float*)d_in[10]; p.lam_im = (const float*)d_in[11]; p.log_dt = (const float*)d_in[12];
  p.b_re = (const float*)d_in[13]; p.b_im = (const float*)d_in[14]; p.c_re = (const float*)d_in[15]; p.c_im = (const float*)d_in[16];
  p.ssm_d = (const float*)d_in[17]; p.w_glu = (const float*)d_in[18]; p.w_out = (const float*)d_in[19]; p.final_g = (const float*)d_in[20];
  p.out = (float*)d_out;
  p.ws = (char*)d_ws;
  hipMemsetAsync((char*)d_ws + OFF_BAR, 0, XCD_BAR_WORDS * sizeof(unsigned), stream);
  void* args[] = {&p};
  hipError_t e = hipLaunchCooperativeKernel((void*)mega, dim3(grid_blocks), dim3(NT), args, SMEM_BYTES, stream);
  if (e != hipSuccess) fprintf(stderr, "coop launch failed: %s (grid %d)\n", hipGetErrorString(e), grid_blocks);
}
```

```cpp
#include <hip/hip_runtime.h>
#include <hip/hip_cooperative_groups.h>
#include <cstdio>
#include <cstdint>
namespace cg = cooperative_groups;

typedef _Float16 h16;
typedef _Float16 half8 __attribute__((ext_vector_type(8)));
typedef _Float16 half4 __attribute__((ext_vector_type(4)));
typedef float f32x16 __attribute__((ext_vector_type(16)));
typedef float f32x4 __attribute__((ext_vector_type(4)));

#define NT 512
#define LAS __attribute__((address_space(3)))
#define MFMA32(a, b, c) __builtin_amdgcn_mfma_f32_32x32x16_f16(a, b, c, 0, 0, 0)
#define MFMA16(a, b, c) __builtin_amdgcn_mfma_f32_16x16x32_f16(a, b, c, 0, 0, 0)

constexpr int D = 1024;
constexpr int NTOK = 32768;
constexpr size_t MiB = 1024 * 1024;
constexpr size_t OFF_W = 0;
constexpr size_t OFF_ROPE = 24 * MiB;
constexpr size_t OFF_ADA = 26 * MiB;
constexpr size_t OFF_LSE = 27 * MiB;
constexpr size_t OFF_ENDS = 30 * MiB;
constexpr size_t OFF_BAR = 38 * MiB;
constexpr size_t OFF_R0 = 40 * MiB;
constexpr size_t OFF_BIG = 104 * MiB;
constexpr size_t OFF_QK = OFF_BIG;
constexpr size_t OFF_VT = OFF_BIG + 96 * MiB;
constexpr size_t OFF_ZC = OFF_BIG + 144 * MiB;
constexpr size_t OFF_O3 = OFF_BIG + 160 * MiB;
constexpr size_t OFF_R1 = OFF_BIG;
constexpr size_t OFF_R2 = OFF_BIG + 64 * MiB;
constexpr size_t OFF_R3 = OFF_BIG + 128 * MiB;
constexpr size_t WA_IN = 0;
constexpr size_t WA_OUT = (size_t)10240 * 1024;
constexpr size_t WS_IN = 0;
constexpr size_t WS_GLU = (size_t)2048 * 1024;
constexpr size_t WS_OUT = (size_t)3072 * 1024;

constexpr int ATT_LDS = 70656;
constexpr int SMEM_BYTES = 147456 + 16;

struct Params {
  const float *x_prompt, *x_sample, *c_prompt, *c_sample, *norm_g, *ada_w, *ada_b, *attn_w_in, *attn_w_out,
      *ssm_w_in, *lam_re, *lam_im, *log_dt, *b_re, *b_im, *c_re, *c_im, *ssm_d, *w_glu, *w_out, *final_g;
  float* out;
  char* ws;
};

__device__ __forceinline__ int otid() { int t = threadIdx.x; asm volatile("" : "+v"(t)); return t; }
__device__ __forceinline__ float afma(float a, float b, float c) { return __builtin_fmaf(a, b, c); }
__device__ __forceinline__ half8 pack8(f32x4 a, f32x4 b) { half8 o = {(h16)a[0], (h16)a[1], (h16)a[2], (h16)a[3], (h16)b[0], (h16)b[1], (h16)b[2], (h16)b[3]}; return o; }
__device__ __forceinline__ int obid() { int b = blockIdx.x; asm volatile("" : "+s"(b)); return b; }
__device__ __forceinline__ int ogdim() { int b = gridDim.x; asm volatile("" : "+s"(b)); return b; }
__device__ __forceinline__ half8 zero8() { float z = 0.f; asm volatile("" : "+v"(z)); f32x4 t = {z, z, z, z}; return __builtin_bit_cast(half8, t); }
__device__ __forceinline__ float shx(float v, int mask, int lane) { return __int_as_float(__builtin_amdgcn_ds_bpermute((lane ^ mask) << 2, __float_as_int(v))); }
__device__ __forceinline__ int seq_of_tok(int t) { return t < 16384 ? (t >> 13) : 2 + ((t - 16384) >> 12); }
__device__ __forceinline__ float silu_f(float x) { return x * __builtin_amdgcn_rcpf(1.f + __expf(-x)); }
__device__ __forceinline__ float sigmoid_f(float x) { return __builtin_amdgcn_rcpf(1.f + __expf(-x)); }
__device__ __forceinline__ float gelu_tanh(float x) {
  float u = 0.7978845608028654f * (x + 0.044715f * x * x * x);
  float t = 1.f - 2.f * __builtin_amdgcn_rcpf(1.f + __expf(2.f * u));
  return 0.5f * x * (1.f + t);
}

__device__ __forceinline__ void sincos_acc(float angf, float& s, float& c) {
  double a = (double)angf;
  double kd = rint(a * 0.6366197723675814);
  double r = a - kd * 1.5707963267948966 - kd * 6.123233995736766e-17;
  int k = ((int)kd) & 3;
  double r2 = r * r;
  double sp = r * (1.0 + r2 * (-1.0 / 6 + r2 * (1.0 / 120 + r2 * (-1.0 / 5040 + r2 * (1.0 / 362880 + r2 * (-1.0 / 39916800 + r2 * (1.0 / 6227020800.0)))))));
  double cp = 1.0 + r2 * (-0.5 + r2 * (1.0 / 24 + r2 * (-1.0 / 720 + r2 * (1.0 / 40320 + r2 * (-1.0 / 3628800 + r2 * (1.0 / 479001600 + r2 * (-1.0 / 87178291200.0)))))));
  double ss = (k & 1) ? cp : sp;
  double cc = (k & 1) ? sp : cp;
  if (k == 1) cc = -cc;
  if (k == 2) { ss = -ss; cc = -cc; }
  if (k == 3) ss = -ss;
  s = (float)ss;
  c = (float)cc;
}

__device__ __forceinline__ void convert_tile(const float* __restrict__ src, h16* __restrict__ dst, int N, int tile, char* smem) {
  float(*t)[129] = (float(*)[129])smem;
  const int ctid = otid();
  int ntn = N >> 7;
  int k0 = (tile / ntn) << 6, n0 = (tile % ntn) << 7;
  int tx = ctid & 31, ty = ctid >> 5;
#pragma unroll
  for (int i = 0; i < 4; ++i) {
    int k = ty + 16 * i;
    float4 v = *(const float4*)(src + (size_t)(k0 + k) * N + n0 + 4 * tx);
    t[k][4 * tx + 0] = v.x; t[k][4 * tx + 1] = v.y; t[k][4 * tx + 2] = v.z; t[k][4 * tx + 3] = v.w;
  }
  __syncthreads();
#pragma unroll
  for (int i = 0; i < 2; ++i) {
    int idx = ctid + 512 * i;
    int nn = idx >> 3, kc = idx & 7;
    half8 o;
#pragma unroll
    for (int j = 0; j < 8; ++j) o[j] = (h16)t[kc * 8 + j][nn];
    *(half8*)(dst + (size_t)(n0 + nn) * 1024 + k0 + kc * 8) = o;
  }
  __syncthreads();
}

__device__ __forceinline__ void convert_layer_weights(const Params& p, int layer, int item0, int nitems_before, char* smem) {
  h16* W = (h16*)(p.ws + OFF_W);
  int j = layer >> 1;
  if ((layer & 1) == 0) {
    const int n_in = 16 * 80, n_out = 128;
    for (int it = item0; it < nitems_before + n_in + n_out; it += ogdim()) {
      int t = it - nitems_before;
      if (t < 0) continue;
      if (t < n_in) convert_tile(p.attn_w_in + (size_t)j * 1024 * 10240, W + WA_IN, 10240, t, smem);
      else convert_tile(p.attn_w_out + (size_t)j * 1024 * 1024, W + WA_OUT, 1024, t - n_in, smem);
    }
  } else {
    const int n_in = 16 * 16, n_g = 128, n_o = 128;
    for (int it = item0; it < nitems_before + n_in + n_g + n_o; it += ogdim()) {
      int t = it - nitems_before;
      if (t < 0) continue;
      if (t < n_in) convert_tile(p.ssm_w_in + (size_t)j * 1024 * 2048, W + WS_IN, 2048, t, smem);
      else if (t < n_in + n_g) convert_tile(p.w_glu + (size_t)j * 1024 * 1024, W + WS_GLU, 1024, t - n_in, smem);
      else convert_tile(p.w_out + (size_t)j * 1024 * 1024, W + WS_OUT, 1024, t - n_in - n_g, smem);
    }
  }
}

__device__ __forceinline__ void phase0(const Params& p, char* smem) {
  const int tid = otid(); const int lane = tid & 63, wave = tid >> 6;
  const int N_ADA = 192, N_ROPE = 512;
  float* ADA = (float*)(p.ws + OFF_ADA);
  float2* ROPE = (float2*)(p.ws + OFF_ROPE);
  int it = obid();
  for (; it < N_ADA; it += ogdim()) {
    int layer = it / 48, cb = it % 48;
    float* sc = (float*)smem;
    float* red = (float*)(smem + 6 * 1024 * 4);
    for (int i = tid; i < 6144; i += NT) {
      int s = i >> 10, k = i & 1023;
      float c = s < 2 ? p.c_prompt[s * 1024 + k] : p.c_sample[(s - 2) * 1024 + k];
      sc[i] = silu_f(c);
    }
    __syncthreads();
    int col = cb * 64 + lane;
    float acc[6] = {0.f, 0.f, 0.f, 0.f, 0.f, 0.f};
    const float* wp = p.ada_w + ((size_t)layer * 1024 + wave * 128) * 3072 + col;
#pragma unroll 1
    for (int k0 = 0; k0 < 128; k0 += 32) {
      float wv[32];
#pragma unroll
      for (int k = 0; k < 32; ++k) wv[k] = wp[(size_t)(k0 + k) * 3072];
#pragma unroll
      for (int k = 0; k < 32; ++k)
#pragma unroll
        for (int s = 0; s < 6; ++s) acc[s] += sc[s * 1024 + wave * 128 + k0 + k] * wv[k];
    }
#pragma unroll
    for (int s = 0; s < 6; ++s) red[(wave * 6 + s) * 64 + lane] = acc[s];
    __syncthreads();
    if (wave == 0) {
#pragma unroll
      for (int s = 0; s < 6; ++s) {
        float v = 0.f;
#pragma unroll
        for (int w8 = 0; w8 < 8; ++w8) v += red[(w8 * 6 + s) * 64 + lane];
        ADA[(layer * 6 + s) * 3072 + col] = v + p.ada_b[layer * 3072 + col];
      }
    }
    __syncthreads();
  }
  for (; it < N_ADA + N_ROPE; it += ogdim()) {
    int idx = (it - N_ADA) * NT + tid;
    int pos = idx >> 5, e = idx & 31;
    float invf = (float)exp(-(double)(2 * e) / 64.0 * 9.210340371976184);
    float ang = (float)pos * invf;
    float s, c;
    sincos_acc(ang, s, c);
    ROPE[idx] = make_float2(c, s);
  }
  convert_layer_weights(p, 0, it, N_ADA + N_ROPE, smem);
}

__device__ __forceinline__ void phase_norm(const Params& p, int layer, char* smem) {
  const int tid = otid(); const int lane = tid & 63, wave = tid >> 6;
  h16* H = (h16*)(p.ws + OFF_R0);
  const float* ADA = (const float*)(p.ws + OFF_ADA);
  const float* g = p.norm_g + layer * 1024;
  int it = obid();
  if (layer == 0) {
    auto rowptr = [&](int row) -> const float4* { return (const float4*)(row < 16384 ? p.x_prompt + (size_t)row * 1024 : p.x_sample + (size_t)(row - 16384) * 1024); };
    float4 gg[4], sh[4], scl[4];
#pragma unroll
    for (int j = 0; j < 4; ++j) gg[j] = *(const float4*)(g + 4 * (lane + 64 * j));
    int cur_seq = -1;
    float4 vn[4];
    if (it < NTOK / 8) {
      const float4* xr = rowptr(it * 8 + wave);
#pragma unroll
      for (int j = 0; j < 4; ++j) vn[j] = xr[lane + 64 * j];
    }
    for (; it < NTOK / 8; it += ogdim()) {
      const int row = it * 8 + wave;
      float4 v[4];
#pragma unroll
      for (int j = 0; j < 4; ++j) v[j] = vn[j];
      const int itn = it + ogdim();
      if (itn < NTOK / 8) {
        const float4* xr = rowptr(itn * 8 + wave);
#pragma unroll
        for (int j = 0; j < 4; ++j) vn[j] = xr[lane + 64 * j];
      }
      const int seq = seq_of_tok(row);
      if (seq != cur_seq) {
        cur_seq = seq;
        const float* ada = ADA + (layer * 6 + seq) * 3072;
#pragma unroll
        for (int j = 0; j < 4; ++j) { sh[j] = *(const float4*)(ada + 4 * (lane + 64 * j)); scl[j] = *(const float4*)(ada + 1024 + 4 * (lane + 64 * j)); }
      }
      float ss = 0.f;
#pragma unroll
      for (int j = 0; j < 4; ++j) ss += v[j].x * v[j].x + v[j].y * v[j].y + v[j].z * v[j].z + v[j].w * v[j].w;
#pragma unroll
      for (int o = 32; o >= 1; o >>= 1) ss += shx(ss, o, lane);
      float rstd = rsqrtf(ss * (1.f / 1024.f) + 1e-6f);
#pragma unroll
      for (int j = 0; j < 4; ++j) {
        int idx = 4 * (lane + 64 * j);
        half4 o;
        o[0] = (h16)(v[j].x * rstd * gg[j].x * (1.f + scl[j].x) + sh[j].x);
        o[1] = (h16)(v[j].y * rstd * gg[j].y * (1.f + scl[j].y) + sh[j].y);
        o[2] = (h16)(v[j].z * rstd * gg[j].z * (1.f + scl[j].z) + sh[j].z);
        o[3] = (h16)(v[j].w * rstd * gg[j].w * (1.f + scl[j].w) + sh[j].w);
        *(half4*)(H + (size_t)row * 1024 + idx) = o;
      }
    }
  } else {
    const h16* X16 = (const h16*)p.out;
    f32x4 gg[2][2], sh[2][2], scl[2][2];
#pragma unroll
    for (int j = 0; j < 2; ++j)
#pragma unroll
      for (int n = 0; n < 2; ++n) gg[j][n] = *(const f32x4*)(g + 8 * (lane + 64 * j) + 4 * n);
    int cur_seq = -1;
    half8 vn[2];
    if (it < NTOK / 8) {
#pragma unroll
      for (int j = 0; j < 2; ++j) vn[j] = *(const half8*)(X16 + (size_t)(it * 8 + wave) * 1024 + 8 * (lane + 64 * j));
    }
    for (; it < NTOK / 8; it += ogdim()) {
      const int row = it * 8 + wave;
      half8 v[2];
#pragma unroll
      for (int j = 0; j < 2; ++j) v[j] = vn[j];
      const int itn = it + ogdim();
      if (itn < NTOK / 8) {
#pragma unroll
        for (int j = 0; j < 2; ++j) vn[j] = *(const half8*)(X16 + (size_t)(itn * 8 + wave) * 1024 + 8 * (lane + 64 * j));
      }
      const int seq = seq_of_tok(row);
      if (seq != cur_seq) {
        cur_seq = seq;
        const float* ada = ADA + (layer * 6 + seq) * 3072;
#pragma unroll
        for (int j = 0; j < 2; ++j)
#pragma unroll
          for (int n = 0; n < 2; ++n) { sh[j][n] = *(const f32x4*)(ada + 8 * (lane + 64 * j) + 4 * n); scl[j][n] = *(const f32x4*)(ada + 1024 + 8 * (lane + 64 * j) + 4 * n); }
      }
      f32x4 f[2][2];
      float ss = 0.f;
#pragma unroll
      for (int j = 0; j < 2; ++j)
#pragma unroll
        for (int n = 0; n < 2; ++n)
#pragma unroll
          for (int k = 0; k < 4; ++k) { const float t = (float)v[j][4 * n + k]; f[j][n][k] = t; ss += t * t; }
#pragma unroll
      for (int o = 32; o >= 1; o >>= 1) ss += shx(ss, o, lane);
      const float rstd = rsqrtf(ss * (1.f / 1024.f) + 1e-6f);
#pragma unroll
      for (int j = 0; j < 2; ++j) {
        const f32x4 lo = f[j][0] * rstd * gg[j][0] * (scl[j][0] + 1.f) + sh[j][0];
        const f32x4 hi = f[j][1] * rstd * gg[j][1] * (scl[j][1] + 1.f) + sh[j][1];
        *(half8*)(H + (size_t)row * 1024 + 8 * (lane + 64 * j)) = pack8(lo, hi);
      }
    }
  }
  if (layer > 0) convert_layer_weights(p, layer, it, NTOK / 8, smem);
}

__device__ __forceinline__ void phase_final_norm(const Params& p) {
  const int tid = otid(); const int lane = tid & 63, wave = tid >> 6;
  const h16* X16 = (const h16*)(p.ws + OFF_R3);
  f32x4 gg[2][2];
#pragma unroll
  for (int j = 0; j < 2; ++j)
#pragma unroll
    for (int n = 0; n < 2; ++n) gg[j][n] = *(const f32x4*)(p.final_g + 8 * (lane + 64 * j) + 4 * n);
  int it = obid();
  half8 vn[2];
  if (it < NTOK / 8) {
#pragma unroll
    for (int j = 0; j < 2; ++j) vn[j] = *(const half8*)(X16 + (size_t)(it * 8 + wave) * 1024 + 8 * (lane + 64 * j));
  }
  for (; it < NTOK / 8; it += ogdim()) {
    const int row = it * 8 + wave;
    half8 v[2];
#pragma unroll
    for (int j = 0; j < 2; ++j) v[j] = vn[j];
    const int itn = it + ogdim();
    if (itn < NTOK / 8) {
#pragma unroll
      for (int j = 0; j < 2; ++j) vn[j] = *(const half8*)(X16 + (size_t)(itn * 8 + wave) * 1024 + 8 * (lane + 64 * j));
    }
    f32x4 f[2][2];
    float ss = 0.f;
#pragma unroll
    for (int j = 0; j < 2; ++j)
#pragma unroll
      for (int n = 0; n < 2; ++n)
#pragma unroll
        for (int k = 0; k < 4; ++k) { const float t = (float)v[j][4 * n + k]; f[j][n][k] = t; ss += t * t; }
#pragma unroll
    for (int o = 32; o >= 1; o >>= 1) ss += shx(ss, o, lane);
    const float rstd = rsqrtf(ss * (1.f / 1024.f) + 1e-6f);
    float* xo = p.out + (size_t)row * 1024;
#pragma unroll
    for (int j = 0; j < 2; ++j)
#pragma unroll
      for (int n = 0; n < 2; ++n) *(f32x4*)(xo + 8 * (lane + 64 * j) + 4 * n) = f[j][n] * rstd * gg[j][n];
  }
}

namespace pg8 {
constexpr int BK = 64, HALF = 128, HTB = HALF * BK * 2, STAGE_BYTES = 8 * HTB;
enum { PK_NONE = 0, PK_P32 = 1, PK_ROPE = 2 };
__device__ __forceinline__ int lds_byte(int r, int c) { const int st = (r >> 4) * 2 + (c >> 5), rr = r & 15, cc = c & 31, ob = rr * 64 + cc * 2; return st * 1024 + (ob ^ (((ob >> 9) & 1) << 5)); }
__device__ __forceinline__ void stage_rc(int b, int& R, int& C) { const int st = b / 1024, sb = b % 1024, swz = sb ^ (((sb >> 9) & 1) << 5); R = (st >> 1) * 16 + swz / 64; C = (st & 1) * 32 + (swz % 64) / 2; }
__device__ __forceinline__ int perm_row(int R, int kind) {
  if (kind == PK_P32) { const int rho = R & 31, n = rho >> 4, i = rho & 15; return (R & ~31) + 8 * (i >> 2) + 4 * n + (i & 3); }
  if (kind == PK_ROPE) { const int rho = R & 31, n = rho >> 4, i = rho & 15; return 2 * (R & ~31) + 8 * (i >> 2) + 4 * n + (i & 3); }
  return R;
}
struct Unit { const char* A; const char* B; unsigned ldb; int pkind; int kind; int pm; int pn; int aux; };
__device__ __forceinline__ void tile_of(int L, int nM, int nN, int& pm, int& pn) {
  const int nwg = nM * nN; int wgid = L;
  { const int q = nwg / 8, r = nwg % 8, xcd = wgid % 8, off = wgid / 8; wgid = (xcd < r ? xcd * (q + 1) : r * (q + 1) + (xcd - r) * q) + off; }
  const int nig = 8 * nN, gid = wgid / nig, fm = gid * 8, gsz = (nM - fm) < 8 ? (nM - fm) : 8;
  pm = fm + ((wgid % nig) % gsz); pn = (wgid % nig) / gsz;
}

template <class Epi, class Sched>
__device__ __forceinline__ void gemm_phase(LAS unsigned char* lds, const Sched& S, const Epi& E, const int tid) {
  const int wid = __builtin_amdgcn_readfirstlane(tid >> 6), lane = tid & 63, wr = wid >> 2, wc = wid & 3, fr = lane & 15, fq = lane >> 4;
  constexpr int K = 1024, nt = K / BK;
  unsigned voffA[2];
#pragma unroll
  for (int i = 0; i < 2; ++i) { int sR, sC; stage_rc(tid * 16 + i * 8192, sR, sC); voffA[i] = (unsigned)(sR * K + sC) * 2u; }
  const size_t kstep = (size_t)(BK * 2);
  const size_t hstepA = (size_t)HALF * K * 2;
  const unsigned ldsw = (unsigned)wid * 1024u;
  const int aoff = lds_byte(wr * 64 + fr, fq * 8), boff = lds_byte(wc * 32 + fr, fq * 8);
#define PG8_SA(b, h) (((b) * 2 + (h)) * HTB)
#define PG8_SB(b, h) ((4 + (b) * 2 + (h)) * HTB)
#define PG8_STAGE(bufoff, gbase, voff) do { _Pragma("unroll") for (int _i = 0; _i < 2; ++_i) \
    __builtin_amdgcn_global_load_lds((const unsigned*)((const char*)(gbase) + (voff)[_i]), (LAS unsigned*)(lds + (bufoff) + ldsw + _i * 8192), 16, 0, 0); } while (0)
#define PG8_LDA(dst, b, h) do { _Pragma("unroll") for (int m = 0; m < 4; ++m) _Pragma("unroll") for (int k = 0; k < 2; ++k) dst[m][k] = *(const LAS half8*)(lds + PG8_SA(b, h) + aoff + m * 2048 + k * 1024); } while (0)
#define PG8_LDB(dst, b, h) do { _Pragma("unroll") for (int n = 0; n < 2; ++n) _Pragma("unroll") for (int k = 0; k < 2; ++k) dst[n][k] = *(const LAS half8*)(lds + PG8_SB(b, h) + boff + n * 2048 + k * 1024); } while (0)
#define PG8_MMA(ai, bj, At, Bt) do { __builtin_amdgcn_s_setprio(1); _Pragma("unroll") for (int m = 0; m < 4; ++m) _Pragma("unroll") for (int n = 0; n < 2; ++n) _Pragma("unroll") for (int k = 0; k < 2; ++k) \
    acc[ai][bj][m][n] = __builtin_amdgcn_mfma_f32_16x16x32_f16(Bt[n][k], At[m][k], acc[ai][bj][m][n], 0, 0, 0); __builtin_amdgcn_s_setprio(0); } while (0)
#define PG8_WAIT_V(n) asm volatile("s_waitcnt vmcnt(" #n ")" ::: "memory")
#define PG8_WAIT_L(n) asm volatile("s_waitcnt lgkmcnt(" #n ")" ::: "memory")
#define PG8_BAR __builtin_amdgcn_s_barrier()
#define PG8_SCHED __builtin_amdgcn_sched_barrier(0)
  Unit cur, nxt; int ui = 0;
  if (!S.next(0, cur)) return;
  f32x4 acc[2][2][4][2];
#pragma unroll
  for (int a = 0; a < 2; ++a)
#pragma unroll
    for (int b = 0; b < 2; ++b)
#pragma unroll
      for (int m = 0; m < 4; ++m)
#pragma unroll
        for (int n = 0; n < 2; ++n) acc[a][b][m][n] = (f32x4){0.f, 0.f, 0.f, 0.f};
  half8 At[4][2], B0[2][2], B1[2][2];
  const char* cA = cur.A; const char* cB = cur.B;
  unsigned vbc[2], vbn[2];
  size_t hBc = (size_t)(cur.pkind == PK_ROPE ? 32 : HALF) * cur.ldb, hBn;
#pragma unroll
  for (int i = 0; i < 2; ++i) { int sR, sC; stage_rc(tid * 16 + i * 8192, sR, sC); vbc[i] = (unsigned)perm_row(sR, cur.pkind) * cur.ldb + (unsigned)sC * 2u; }
  PG8_STAGE(PG8_SB(0, 0), cB, vbc); PG8_STAGE(PG8_SA(0, 0), cA, voffA); PG8_STAGE(PG8_SB(0, 1), cB + hBc, vbc); PG8_STAGE(PG8_SA(0, 1), cA + hstepA, voffA);
  if (wr == 1) PG8_BAR;
  PG8_WAIT_V(4); PG8_BAR;
  PG8_STAGE(PG8_SB(1, 0), cB + kstep, vbc); PG8_STAGE(PG8_SA(1, 0), cA + kstep, voffA); PG8_STAGE(PG8_SB(1, 1), cB + hBc + kstep, vbc);
  PG8_WAIT_V(6); PG8_BAR;
  for (;;) {
    const bool has_next = S.next(ui + 1, nxt);
    const char* nA = has_next ? nxt.A : cA; const char* nB = has_next ? nxt.B : cB;
    hBn = has_next ? (size_t)(nxt.pkind == PK_ROPE ? 32 : HALF) * nxt.ldb : hBc;
#pragma unroll
    for (int i = 0; i < 2; ++i) { int sR, sC; stage_rc(tid * 16 + i * 8192, sR, sC); vbn[i] = has_next ? ((unsigned)perm_row(sR, nxt.pkind) * nxt.ldb + (unsigned)sC * 2u) : vbc[i]; }
    for (int t = 0; t < nt; t += 2) {
      const bool last = (t == nt - 2);
      const char* a1 = cA + (size_t)(t + 1) * kstep;
      const char* a2 = last ? nA : cA + (size_t)(t + 2) * kstep; const char* b2 = last ? nB : cB + (size_t)(t + 2) * kstep;
      const char* a3 = a2 + kstep; const char* b3 = b2 + kstep;
      unsigned vb[2]; vb[0] = last ? vbn[0] : vbc[0]; vb[1] = last ? vbn[1] : vbc[1];
      const size_t hb = last ? hBn : hBc;
      PG8_LDB(B0, 0, 0); PG8_SCHED; PG8_LDA(At, 0, 0); PG8_STAGE(PG8_SA(1, 1), a1 + hstepA, voffA);
      PG8_WAIT_L(8); PG8_BAR; PG8_WAIT_L(0); PG8_MMA(0, 0, At, B0); PG8_BAR; PG8_SCHED;
      PG8_LDB(B1, 0, 1); PG8_STAGE(PG8_SB(0, 0), b2, vb);
      PG8_BAR; PG8_WAIT_L(0); PG8_MMA(0, 1, At, B1); PG8_BAR;
      PG8_LDA(At, 0, 1); PG8_STAGE(PG8_SA(0, 0), a2, voffA);
      PG8_BAR; PG8_WAIT_L(0); PG8_MMA(1, 0, At, B0); PG8_BAR; PG8_SCHED;
      PG8_STAGE(PG8_SB(0, 1), b2 + hb, vb);
      PG8_WAIT_V(6); PG8_BAR; PG8_MMA(1, 1, At, B1); PG8_BAR;
      PG8_LDB(B0, 1, 0); PG8_SCHED; PG8_LDA(At, 1, 0); PG8_STAGE(PG8_SA(0, 1), a2 + hstepA, voffA);
      PG8_WAIT_L(8); PG8_BAR; PG8_WAIT_L(0); PG8_MMA(0, 0, At, B0); PG8_BAR; PG8_SCHED;
      PG8_LDB(B1, 1, 1); PG8_STAGE(PG8_SB(1, 0), b3, vb);
      PG8_BAR; PG8_WAIT_L(0); PG8_MMA(0, 1, At, B1); PG8_BAR;
      PG8_LDA(At, 1, 1); PG8_STAGE(PG8_SA(1, 0), a3, voffA);
      PG8_BAR; PG8_WAIT_L(0); PG8_MMA(1, 0, At, B0); PG8_BAR; PG8_SCHED;
      PG8_STAGE(PG8_SB(1, 1), b3 + hb, vb);
      PG8_WAIT_V(6); PG8_BAR; PG8_MMA(1, 1, At, B1); PG8_BAR;
    }
    E(acc, cur, wr, wc, fr, fq);
    if (!has_next) break;
#pragma unroll
    for (int a = 0; a < 2; ++a)
#pragma unroll
      for (int b = 0; b < 2; ++b)
#pragma unroll
        for (int m = 0; m < 4; ++m)
#pragma unroll
          for (int n = 0; n < 2; ++n) acc[a][b][m][n] = (f32x4){0.f, 0.f, 0.f, 0.f};
    cur = nxt; cA = nA; cB = nB; hBc = hBn; vbc[0] = vbn[0]; vbc[1] = vbn[1]; ++ui;
  }
  PG8_WAIT_V(0);
  if (wr == 0) PG8_BAR;
  PG8_BAR;
#undef PG8_SA
#undef PG8_SB
#undef PG8_STAGE
#undef PG8_LDA
#undef PG8_LDB
#undef PG8_MMA
#undef PG8_WAIT_V
#undef PG8_WAIT_L
#undef PG8_BAR
#undef PG8_SCHED
}
}
typedef f32x4 acc_t[2][2][4][2];


enum { UK_QK = 0, UK_Z = 1, UK_VT = 2 };
struct AttnInSched {
  const char* H; const char* W; int tok0; int S;
  __device__ __forceinline__ bool next(int i, pg8::Unit& u) const {
    const int L = i * ogdim() + obid();
    if (L >= 1280) return false;
    if (L < 896) {
      int pm, pn; pg8::tile_of(L, 32, 28, pm, pn);
      u.pm = pm; u.ldb = 2048u;
      u.A = H + (size_t)(tok0 + pm * 256) * 2048;
      if (pn < 24) {
        const int g = pn >> 3, qk = (pn >> 2) & 1, cb = pn & 3;
        u.kind = UK_QK; u.pkind = pg8::PK_ROPE; u.pn = pn; u.aux = (g * 2 + qk) * 1024 + cb * 256;
        u.B = W + (size_t)(g * 3072 + qk * 1024 + cb * 256) * 2048;
      } else {
        u.kind = UK_Z; u.pkind = pg8::PK_P32; u.pn = pn - 24; u.aux = 0;
        u.B = W + (size_t)(9216 + (pn - 24) * 256) * 2048;
      }
    } else {
      int pm, pn; pg8::tile_of(L - 896, 12, 32, pm, pn);
      const int g = pm >> 2, fb = pm & 3;
      const int d = g == 0 ? 1 : (g == 1 ? 4 : 16);
      const int m = S / d;
      const int tp0 = pn * 256;
      const int sl = tp0 / S, w = tp0 % S, r = w / m, i0 = w % m;
      u.kind = UK_VT; u.pkind = pg8::PK_P32; u.pm = fb; u.pn = pn; u.aux = g;
      u.A = W + (size_t)(g * 3072 + 2048 + fb * 256) * 2048;
      u.B = H + (size_t)(tok0 + sl * S + i0 * d + r) * 2048;
      u.ldb = (unsigned)d * 2048u;
    }
    return true;
  }
};
struct AttnInEpi {
  h16* QK; h16* VT; h16* ZC; const float4* ROPE; int S;
  __device__ __forceinline__ void operator()(const acc_t& acc, const pg8::Unit& u, int wr, int wc, int fr, int fq) const {
    if (u.kind == UK_QK) {
      const float qs = ((u.aux >> 10) & 1) ? 1.f : 0.125f * 1.4426950408889634f;
      const int e0 = 8 * fq;
      const int tl0 = u.pm * 256 + wr * 64 + fr;
      const int ib = (((tl0) & (S - 1)) * 32 + e0) >> 1, ir = (16 * 32 + e0) >> 1;
      float c[8], sn[8], rc[8], rs[8];
#pragma unroll
      for (int k = 0; k < 4; ++k) {
        const float4 bv = ROPE[ib + k], rv = ROPE[ir + k];
        c[2 * k] = bv.x; sn[2 * k] = bv.y; c[2 * k + 1] = bv.z; sn[2 * k + 1] = bv.w;
        rc[2 * k] = rv.x; rs[2 * k] = rv.y; rc[2 * k + 1] = rv.z; rs[2 * k + 1] = rv.w;
      }
#pragma unroll
      for (int ai = 0; ai < 2; ++ai) {
#pragma unroll
        for (int m = 0; m < 4; ++m) {
          const int tl = tl0 + ai * 128 + m * 16;
          half8 o1, o2;
#pragma unroll
          for (int n = 0; n < 2; ++n) {
            const f32x4 t1 = acc[ai][0][m][n], t2 = acc[ai][1][m][n];
#pragma unroll
            for (int j = 0; j < 4; ++j) {
              o1[4 * n + j] = (h16)((t1[j] * c[4 * n + j] - t2[j] * sn[4 * n + j]) * qs);
              o2[4 * n + j] = (h16)((t2[j] * c[4 * n + j] + t1[j] * sn[4 * n + j]) * qs);
            }
          }
          h16* dst = QK + (size_t)tl * 6144 + u.aux + 64 * wc + e0;
          *(half8*)dst = o1;
          *(half8*)(dst + 32) = o2;
          const int nrot = (m < 3) ? 1 : (ai == 0 ? 5 : 0);
#pragma unroll
          for (int k = 0; k < nrot; ++k)
#pragma unroll
            for (int j = 0; j < 8; ++j) { const float cn = c[j] * rc[j] - sn[j] * rs[j], sx = sn[j] * rc[j] + c[j] * rs[j]; c[j] = cn; sn[j] = sx; }
        }
      }
    } else if (u.kind == UK_Z) {
#pragma unroll
      for (int ai = 0; ai < 2; ++ai)
#pragma unroll
        for (int m = 0; m < 4; ++m) {
          const int tl = u.pm * 256 + ai * 128 + wr * 64 + m * 16 + fr;
#pragma unroll
          for (int bj = 0; bj < 2; ++bj) {
            f32x4 a = acc[ai][bj][m][0], b = acc[ai][bj][m][1];
#pragma unroll
            for (int j = 0; j < 4; ++j) { a[j] = silu_f(a[j]); b[j] = silu_f(b[j]); }
            *(half8*)(ZC + (size_t)tl * 1024 + u.pn * 256 + bj * 128 + wc * 32 + 8 * fq) = pack8(a, b);
          }
        }
    } else {
#pragma unroll
      for (int ai = 0; ai < 2; ++ai)
#pragma unroll
        for (int m = 0; m < 4; ++m) {
          const int f = u.pm * 256 + ai * 128 + wr * 64 + m * 16 + fr;
#pragma unroll
          for (int bj = 0; bj < 2; ++bj)
            *(half8*)(VT + ((size_t)u.aux * 1024 + f) * 8192 + u.pn * 256 + bj * 128 + wc * 32 + 8 * fq) = pack8(acc[ai][bj][m][0], acc[ai][bj][m][1]);
        }
    }
  }
};
__device__ __forceinline__ void phase_attn_in(const Params& p, int chunk, char* smem) {
  const int tid = otid();
  AttnInSched S; S.H = p.ws + OFF_R0; S.W = p.ws + OFF_W + WA_IN * 2; S.tok0 = chunk * 8192; S.S = chunk < 2 ? 8192 : 4096;
  AttnInEpi E; E.QK = (h16*)(p.ws + OFF_QK); E.VT = (h16*)(p.ws + OFF_VT); E.ZC = (h16*)(p.ws + OFF_ZC); E.ROPE = (const float4*)(p.ws + OFF_ROPE); E.S = S.S;
  pg8::gemm_phase(( LAS unsigned char*)smem, S, E, tid);
}

struct PlainSched {
  const char* A; const char* W; int nN; int pkind;
  __device__ __forceinline__ bool next(int i, pg8::Unit& u) const {
    const int L = i * ogdim() + obid();
    if (L >= 128 * nN) return false;
    int pm, pn; pg8::tile_of(L, 128, nN, pm, pn);
    u.pm = pm; u.pn = pn; u.ldb = 2048u; u.kind = 0; u.pkind = pkind; u.aux = 0;
    u.A = A + (size_t)pm * 256 * 2048; u.B = W + (size_t)pn * 256 * 2048;
    return true;
  }
};
struct OutEpi {
  const float* xp; const float* xs; const h16* x16in; h16* x16out; const float* ADA; int layer;
  __device__ __forceinline__ void operator()(const acc_t& acc, const pg8::Unit& u, int wr, int wc, int fr, int fq) const {
    const int seq = seq_of_tok(u.pm * 256);
    const float* gate = ADA + (layer * 6 + seq) * 3072 + 2048;
    const int col0 = u.pn * 256 + wc * 32 + 8 * fq;
    f32x4 gv[2][2];
#pragma unroll
    for (int bj = 0; bj < 2; ++bj)
#pragma unroll
      for (int n = 0; n < 2; ++n) gv[bj][n] = *(const f32x4*)(gate + col0 + bj * 128 + 4 * n);
    const int row0 = u.pm * 256 + wr * 64 + fr;
    if (layer == 0) {
      const float* xbase = (row0 < 16384 ? xp : xs - (size_t)16384 * 1024);
      f32x4 xv[2][2], xn[2][2];
#pragma unroll
      for (int bj = 0; bj < 2; ++bj)
#pragma unroll
        for (int n = 0; n < 2; ++n) xv[bj][n] = *(const f32x4*)(xbase + (size_t)row0 * 1024 + col0 + bj * 128 + 4 * n);
#pragma unroll
      for (int k = 0; k < 8; ++k) {
        const int ai = k >> 2, m = k & 3;
        const int row = row0 + ai * 128 + m * 16;
        if (k < 7) {
          const int rn = row0 + ((k + 1) >> 2) * 128 + ((k + 1) & 3) * 16;
#pragma unroll
          for (int bj = 0; bj < 2; ++bj)
#pragma unroll
            for (int n = 0; n < 2; ++n) xn[bj][n] = *(const f32x4*)(xbase + (size_t)rn * 1024 + col0 + bj * 128 + 4 * n);
        }
#pragma unroll
        for (int bj = 0; bj < 2; ++bj)
          *(half8*)(x16out + (size_t)row * 1024 + col0 + bj * 128) = pack8(xv[bj][0] + gv[bj][0] * acc[ai][bj][m][0], xv[bj][1] + gv[bj][1] * acc[ai][bj][m][1]);
#pragma unroll
        for (int bj = 0; bj < 2; ++bj)
#pragma unroll
          for (int n = 0; n < 2; ++n) xv[bj][n] = xn[bj][n];
        asm volatile("" ::: "memory");
      }
    } else {
      half8 xv[2], xn[2];
#pragma unroll
      for (int bj = 0; bj < 2; ++bj) xv[bj] = *(const half8*)(x16in + (size_t)row0 * 1024 + col0 + bj * 128);
#pragma unroll
      for (int k = 0; k < 8; ++k) {
        const int ai = k >> 2, m = k & 3;
        const int row = row0 + ai * 128 + m * 16;
        if (k < 7) {
          const int rn = row0 + ((k + 1) >> 2) * 128 + ((k + 1) & 3) * 16;
#pragma unroll
          for (int bj = 0; bj < 2; ++bj) xn[bj] = *(const half8*)(x16in + (size_t)rn * 1024 + col0 + bj * 128);
        }
#pragma unroll
        for (int bj = 0; bj < 2; ++bj) {
          f32x4 lo, hi;
#pragma unroll
          for (int j = 0; j < 4; ++j) { lo[j] = (float)xv[bj][j]; hi[j] = (float)xv[bj][4 + j]; }
          *(half8*)(x16out + (size_t)row * 1024 + col0 + bj * 128) = pack8(lo + gv[bj][0] * acc[ai][bj][m][0], hi + gv[bj][1] * acc[ai][bj][m][1]);
        }
#pragma unroll
        for (int bj = 0; bj < 2; ++bj) xv[bj] = xn[bj];
        asm volatile("" ::: "memory");
      }
    }
  }
};
__device__ __forceinline__ void phase_out_gemm(const Params& p, int layer, const char* A, const char* Wt, char* smem) {
  const int tid = otid();
  PlainSched S; S.A = A; S.W = Wt; S.nN = 4; S.pkind = pg8::PK_P32;
  OutEpi E; E.xp = p.x_prompt; E.xs = p.x_sample; E.x16in = (const h16*)p.out; E.x16out = (layer == 3) ? (h16*)(p.ws + OFF_R3) : (h16*)p.out;
  E.ADA = (const float*)(p.ws + OFF_ADA); E.layer = layer;
  pg8::gemm_phase((LAS unsigned char*)smem, S, E, tid);
}

struct SsmInEpi {
  h16* U; h16* Z;
  __device__ __forceinline__ void operator()(const acc_t& acc, const pg8::Unit& u, int wr, int wc, int fr, int fq) const {
    const bool isz = u.pn >= 4;
    h16* dstb = (isz ? Z : U) + (u.pn & 3) * 256 + wc * 32 + 8 * fq;
#pragma unroll
    for (int ai = 0; ai < 2; ++ai)
#pragma unroll
      for (int m = 0; m < 4; ++m) {
        const int row = u.pm * 256 + ai * 128 + wr * 64 + m * 16 + fr;
#pragma unroll
        for (int bj = 0; bj < 2; ++bj) {
          f32x4 a = acc[ai][bj][m][0], b = acc[ai][bj][m][1];
          if (isz) {
#pragma unroll
            for (int j = 0; j < 4; ++j) { a[j] = silu_f(a[j]); b[j] = silu_f(b[j]); }
          }
          *(half8*)(dstb + (size_t)row * 1024 + bj * 128) = pack8(a, b);
        }
      }
  }
};
__device__ __forceinline__ void phase_ssm_in(const Params& p, char* smem) {
  const int tid = otid();
  PlainSched S; S.A = p.ws + OFF_R0; S.W = p.ws + OFF_W + WS_IN * 2; S.nN = 8; S.pkind = pg8::PK_P32;
  SsmInEpi E; E.U = (h16*)(p.ws + OFF_R1); E.Z = (h16*)(p.ws + OFF_R2);
  pg8::gemm_phase((LAS unsigned char*)smem, S, E, tid);
}

struct GluEpi {
  const h16* G; const h16* Z; h16* Y2;
  __device__ __forceinline__ void operator()(const acc_t& acc, const pg8::Unit& u, int wr, int wc, int fr, int fq) const {
    const size_t o0 = (size_t)(u.pm * 256 + wr * 64 + fr) * 1024 + u.pn * 256 + wc * 32 + 8 * fq;
    half8 gv[2], zv[2], gn[2], zn[2];
#pragma unroll
    for (int bj = 0; bj < 2; ++bj) { gv[bj] = *(const half8*)(G + o0 + bj * 128); zv[bj] = *(const half8*)(Z + o0 + bj * 128); }
#pragma unroll
    for (int ai = 0; ai < 2; ++ai)
#pragma unroll
      for (int m = 0; m < 4; ++m) {
        const size_t orow = o0 + (size_t)(ai * 128 + m * 16) * 1024;
        if (ai * 4 + m < 7) {
          const size_t onx = o0 + (size_t)(((ai * 4 + m + 1) >> 2) * 128 + ((ai * 4 + m + 1) & 3) * 16) * 1024;
#pragma unroll
          for (int bj = 0; bj < 2; ++bj) { gn[bj] = *(const half8*)(G + onx + bj * 128); zn[bj] = *(const half8*)(Z + onx + bj * 128); }
        }
#pragma unroll
        for (int bj = 0; bj < 2; ++bj) {
          const f32x4 a = acc[ai][bj][m][0], b = acc[ai][bj][m][1];
          half8 r;
#pragma unroll
          for (int j = 0; j < 4; ++j) {
            r[j] = (h16)((float)gv[bj][j] * sigmoid_f(a[j]) * (float)zv[bj][j]);
            r[4 + j] = (h16)((float)gv[bj][4 + j] * sigmoid_f(b[j]) * (float)zv[bj][4 + j]);
          }
          *(half8*)(Y2 + orow + bj * 128) = r;
        }
#pragma unroll
        for (int bj = 0; bj < 2; ++bj) { gv[bj] = gn[bj]; zv[bj] = zn[bj]; }
        asm volatile("" ::: "memory");
      }
  }
};
__device__ __forceinline__ void phase_ssm_glu(const Params& p, char* smem) {
  const int tid = otid();
  PlainSched S; S.A = p.ws + OFF_R0; S.W = p.ws + OFF_W + WS_GLU * 2; S.nN = 4; S.pkind = pg8::PK_P32;
  GluEpi E; E.G = (const h16*)(p.ws + OFF_R0); E.Z = (const h16*)(p.ws + OFF_R2); E.Y2 = (h16*)(p.ws + OFF_R1);
  pg8::gemm_phase((LAS unsigned char*)smem, S, E, tid);
}

__device__ __forceinline__ void sub_barrier(volatile LAS unsigned* cnt, unsigned& target, int lane) {
  asm volatile("s_waitcnt vmcnt(0) lgkmcnt(0)" ::: "memory");
  if (lane == 0) {
    __hip_atomic_fetch_add((LAS unsigned*)cnt, 1u, __ATOMIC_RELAXED, __HIP_MEMORY_SCOPE_WORKGROUP);
    while (__hip_atomic_load((LAS unsigned*)cnt, __ATOMIC_RELAXED, __HIP_MEMORY_SCOPE_WORKGROUP) < target) __builtin_amdgcn_s_sleep(1);
  }
  target += 4u;
  asm volatile("" ::: "memory");
}
__device__ __forceinline__ void phase_attn(const Params& p, int chunk, char* smem) {
  const int tid0 = otid(), lane = tid0 & 63, wave8 = tid0 >> 6;
  const int sub = wave8 >> 2, wave = wave8 & 3, tid = tid0 & 255;
  const h16* QK = (const h16*)(p.ws + OFF_QK);
  const h16* VT = (const h16*)(p.ws + OFF_VT);
  h16* O3 = (h16*)(p.ws + OFF_O3);
  float* LSE = (float*)(p.ws + OFF_LSE);
  const int S = chunk < 2 ? 8192 : 4096;
  constexpr int KROW = 72, VROW = 264;
  h16* Ks = (h16*)(smem + sub * ATT_LDS);
  h16* Vs = (h16*)(smem + sub * ATT_LDS + 256 * KROW * 2);
  volatile LAS unsigned* cnt = (volatile LAS unsigned*)(smem + 2 * ATT_LDS) + sub * 32;
  if (tid0 < 64) ((volatile LAS unsigned*)(smem + 2 * ATT_LDS))[tid0] = 0u;
  __syncthreads();
  unsigned target = 4u;
  const int n = lane & 31, hh = lane >> 5;
  const int qw = wave * 32;
  const int NIT = 3 * 64 * 8;
  auto decode = [&](int it0, int& hd, int& g, int& d, int& m, int& sl, int& r, int& i0) {
    const int it = it0 * 2 + sub;
    hd = it & 15; const int rest = it >> 4;
    g = rest / 64; const int blk = rest % 64;
    d = g == 0 ? 1 : (g == 1 ? 4 : 16);
    m = S / d;
    const int tp0 = blk * 128;
    sl = tp0 / S; const int w = tp0 % S; r = w / m; i0 = w % m;
  };
  half8 kreg[8], vreg[8], qpre[4];
  auto load_kq = [&](int it0) {
    int hd, g, d, m, sl, r, i0; decode(it0, hd, g, d, m, sl, r, i0);
#pragma unroll
    for (int itx = 0; itx < 8; ++itx) {
      const int idx = tid + 256 * itx;
      const int row = idx >> 3, ch = idx & 7;
      const int kj = i0 - 64 + row;
      half8 v = zero8();
      if (kj >= 0 && kj < m) v = *(const half8*)(QK + (size_t)(sl * S + kj * d + r) * 6144 + (g * 2 + 1) * 1024 + hd * 64 + ch * 8);
      kreg[itx] = v;
    }
  };
  auto load_v = [&](int it0) {
    int hd, g, d, m, sl, r, i0; decode(it0, hd, g, d, m, sl, r, i0);
    const h16* qp = QK + (size_t)(sl * S + (i0 + qw + n) * d + r) * 6144 + (g * 2) * 1024 + hd * 64 + hh * 8;
#pragma unroll
    for (int ks = 0; ks < 4; ++ks) qpre[ks] = *(const half8*)(qp + ks * 16);
#pragma unroll
    for (int itx = 0; itx < 8; ++itx) {
      const int idx = tid + 256 * itx;
      const int row = idx >> 5, ch = idx & 31;
      const int kj = i0 - 64 + ch * 8;
      half8 v = zero8();
      if (kj >= 0 && kj < m) v = *(const half8*)(VT + ((size_t)g * 1024 + hd * 64 + row) * 8192 + sl * S + r * m + kj);
      vreg[itx] = v;
    }
  };
  int it0 = obid();
  if (it0 < NIT) { load_kq(it0); load_v(it0); }
  for (; it0 < NIT; it0 += ogdim()) {
    int hd, g, d, m, sl, r, i0; decode(it0, hd, g, d, m, sl, r, i0);
    const int itn = it0 + ogdim();
#pragma unroll
    for (int itx = 0; itx < 8; ++itx) { const int idx = tid + 256 * itx; *(half8*)(Ks + (idx >> 3) * KROW + (idx & 7) * 8) = kreg[itx]; }
#pragma unroll
    for (int itx = 0; itx < 8; ++itx) { const int idx = tid + 256 * itx; *(half8*)(Vs + (idx >> 5) * VROW + (idx & 31) * 8) = vreg[itx]; }
    sub_barrier(cnt, target, lane);
    if (itn < NIT) load_kq(itn);
    f32x16 sc[5];
#pragma unroll
    for (int kb = 0; kb < 5; ++kb) {
#pragma unroll
      for (int i = 0; i < 16; ++i) sc[kb][i] = 0.f;
#pragma unroll
      for (int ks = 0; ks < 4; ++ks) {
        half8 kf = *(const half8*)(Ks + (qw + kb * 32 + n) * KROW + ks * 16 + hh * 8);
        sc[kb] = MFMA32(kf, qpre[ks], sc[kb]);
      }
      __builtin_amdgcn_sched_barrier(0);
    }
    if (itn < NIT) load_v(itn);
    const int qi = i0 + qw + n;
    const bool edge = (i0 + qw < 64) || (i0 + qw + 96 > m);
    if (edge) {
      const int lo = max(qi - 64, 0), hi = min(qi + 64, m - 1);
#pragma unroll
      for (int kb = 0; kb < 5; ++kb)
#pragma unroll
        for (int i = 0; i < 16; ++i) {
          int kj = i0 + qw - 64 + kb * 32 + 8 * (i >> 2) + 4 * hh + (i & 3);
          sc[kb][i] = (kj >= lo && kj <= hi) ? sc[kb][i] : -1e30f;
        }
    } else {
      const int nn0 = n - 4 * hh;
#pragma unroll
      for (int i = 0; i < 16; ++i) {
        const int ci = 8 * (i >> 2) + (i & 3);
        sc[0][i] = (ci >= nn0) ? sc[0][i] : -1e30f;
        sc[4][i] = (ci <= nn0) ? sc[4][i] : -1e30f;
      }
    }
    float mx = -1e30f;
#pragma unroll
    for (int kb = 0; kb < 5; ++kb)
#pragma unroll
      for (int i = 0; i < 16; ++i) mx = fmaxf(mx, sc[kb][i]);
    mx = fmaxf(mx, shx(mx, 32, lane));
    float sum = 0.f;
    half8 pfa[5][2];
#pragma unroll
    for (int kb = 0; kb < 5; ++kb)
#pragma unroll
      for (int i = 0; i < 16; ++i) {
        float pv = __builtin_amdgcn_exp2f(sc[kb][i] - mx);
        pfa[kb][i >> 3][i & 7] = (h16)pv;
        sum += pv;
      }
    sum += shx(sum, 32, lane);
    asm volatile("" : "+v"(pfa[0][0]), "+v"(pfa[0][1]), "+v"(pfa[1][0]), "+v"(pfa[1][1]), "+v"(pfa[2][0]), "+v"(pfa[2][1]), "+v"(pfa[3][0]), "+v"(pfa[3][1]), "+v"(pfa[4][0]), "+v"(pfa[4][1]));
    f32x16 oacc[2];
#pragma unroll
    for (int mb = 0; mb < 2; ++mb)
#pragma unroll
      for (int i = 0; i < 16; ++i) oacc[mb][i] = 0.f;
#pragma unroll
    for (int kb = 0; kb < 5; ++kb)
#pragma unroll
      for (int s2 = 0; s2 < 2; ++s2) {
        const half8 pf = pfa[kb][s2];
#pragma unroll
        for (int mb = 0; mb < 2; ++mb) {
          const h16* vp = Vs + (mb * 32 + n) * VROW + qw + kb * 32 + 16 * s2 + 4 * hh;
          half4 v0 = *(const half4*)(vp), v1 = *(const half4*)(vp + 8);
          half8 vf = {v0[0], v0[1], v0[2], v0[3], v1[0], v1[1], v1[2], v1[3]};
          oacc[mb] = MFMA32(vf, pf, oacc[mb]);
        }
        __builtin_amdgcn_sched_barrier(0);
      }
    float inv = 1.f / sum;
    int tl = sl * S + qi * d + r;
    h16* op = O3 + ((size_t)g * 8192 + tl) * 1024 + hd * 64;
#pragma unroll
    for (int mb = 0; mb < 2; ++mb)
#pragma unroll
      for (int pq = 0; pq < 2; ++pq) {
        union { half4 h; int w[2]; } he, ho, rv;
#pragma unroll
        for (int rr = 0; rr < 4; ++rr) { he.h[rr] = (h16)(oacc[mb][8 * pq + rr] * inv); ho.h[rr] = (h16)(oacc[mb][8 * pq + 4 + rr] * inv); }
        const int s0 = hh ? he.w[0] : ho.w[0], s1 = hh ? he.w[1] : ho.w[1];
        rv.w[0] = __builtin_amdgcn_ds_bpermute((lane ^ 32) << 2, s0);
        rv.w[1] = __builtin_amdgcn_ds_bpermute((lane ^ 32) << 2, s1);
        const half4 lo = hh ? rv.h : he.h, hi = hh ? ho.h : rv.h;
        const half8 o = {lo[0], lo[1], lo[2], lo[3], hi[0], hi[1], hi[2], hi[3]};
        *(half8*)(op + mb * 32 + 8 * (2 * pq + hh)) = o;
      }
    if (hh == 0) LSE[((size_t)g * 8192 + tl) * 16 + hd] = (mx + __builtin_amdgcn_logf(sum)) * 0.6931471805599453f;
    sub_barrier(cnt, target, lane);
  }
  __syncthreads();
}

__device__ __forceinline__ void phase_attn_combine(const Params& p, int chunk) {
  const h16* O3 = (const h16*)(p.ws + OFF_O3);
  const float* LSE = (const float*)(p.ws + OFF_LSE);
  const h16* ZC = (const h16*)(p.ws + OFF_ZC);
  h16* YA = (h16*)(p.ws + OFF_R0) + (size_t)chunk * 8192 * 1024;
  for (int it = obid(); it < 8192 * 128 / NT; it += ogdim()) {
    int idx = it * NT + otid();
    int tl = idx >> 7, c8 = idx & 127;
    int hd = c8 >> 3;
    float l0 = LSE[((size_t)0 * 8192 + tl) * 16 + hd], l1 = LSE[((size_t)1 * 8192 + tl) * 16 + hd], l2 = LSE[((size_t)2 * 8192 + tl) * 16 + hd];
    float mx = fmaxf(l0, fmaxf(l1, l2));
    float w0 = __expf(l0 - mx), w1 = __expf(l1 - mx), w2 = __expf(l2 - mx);
    float inv = __builtin_amdgcn_rcpf(w0 + w1 + w2);
    w0 *= inv; w1 *= inv; w2 *= inv;
    size_t off = (size_t)tl * 1024 + c8 * 8;
    half8 a = *(const half8*)(O3 + off), b = *(const half8*)(O3 + (size_t)8192 * 1024 + off), c = *(const half8*)(O3 + (size_t)2 * 8192 * 1024 + off);
    half8 z = *(const half8*)(ZC + off);
    half8 o;
#pragma unroll
    for (int j = 0; j < 8; ++j) o[j] = (h16)((w0 * (float)a[j] + w1 * (float)b[j] + w2 * (float)c[j]) * (float)z[j]);
    *(half8*)(YA + off) = o;
  }
}

struct ScanPar { float lbr[2], lbi[2], nlbi[2], dt; half8 Bop[4]; half8 Cop[4]; };
__device__ __forceinline__ void scan_setup(const Params& p, int j, int dir, int g, int lane, bool needC, ScanPar& P) {
  const int n = lane & 31, hh = lane >> 5;
  const size_t pbase = (((size_t)j * 2 + dir) * 64 + g);
  const float dt = __expf(p.log_dt[pbase]);
  P.dt = dt;
  float fr[2], fi[2];
#pragma unroll
  for (int s = 0; s < 2; ++s) {
    int st = n + 32 * s;
    float lre = fminf(p.lam_re[pbase * 64 + st], -1e-4f);
    float lim = p.lam_im[pbase * 64 + st];
    float zr = lre * dt, zi = lim * dt;
    float er = __expf(zr);
    float sn, cs, snh, csh;
    sincos_acc(zi, sn, cs);
    sincos_acc(0.5f * zi, snh, csh);
    P.lbr[s] = er * cs;
    P.lbi[s] = er * sn;
    P.nlbi[s] = -P.lbi[s];
    float nr = expm1f(zr) * cs - 2.f * snh * snh, ni = er * sn;
    float den = 1.f / (zr * zr + zi * zi);
    fr[s] = (nr * zr + ni * zi) * den;
    fi[s] = (ni * zr - nr * zi) * den;
  }
#pragma unroll
  for (int s = 0; s < 2; ++s) {
    int st = n + 32 * s;
    const float* br = p.b_re + (pbase * 64 + st) * 16 + 8 * hh;
    const float* bi = p.b_im + (pbase * 64 + st) * 16 + 8 * hh;
#pragma unroll
    for (int jj = 0; jj < 8; ++jj) {
      float a = br[jj], b = bi[jj];
      P.Bop[2 * s][jj] = (h16)(fr[s] * a - fi[s] * b);
      P.Bop[2 * s + 1][jj] = (h16)(fr[s] * b + fi[s] * a);
    }
  }
  if (needC) {
    int ch = lane & 15, qd = lane >> 4;
#pragma unroll
    for (int kb = 0; kb < 4; ++kb)
#pragma unroll
      for (int jj = 0; jj < 8; ++jj) {
        int kap = 32 * kb + 8 * qd + jj;
        int np = kap >> 2, which = kap & 3;
        int st = np + 32 * (which >> 1);
        size_t ci = (pbase * 16 + ch) * 64 + st;
        P.Cop[kb][jj] = (which & 1) ? (h16)(-p.c_im[ci]) : (h16)(p.c_re[ci]);
      }
  }
}
template <int MODE>
__device__ __forceinline__ void scan_run(const Params& p, const ScanPar& P, const int dir, const int g, const int sp, const int lane, h16* X, const f32x4 dsk) {
  const int n = lane & 31, hh = lane >> 5;
  const h16* U = (const h16*)(p.ws + OFF_R1);
  h16* Y = (h16*)(p.ws + OFF_R0);
  float4* ENDS = (float4*)(p.ws + OFF_ENDS);
  constexpr int XROW = 136;
  const int pairtok = sp * 512;
  const int S = pairtok < 16384 ? 8192 : 4096;
  const int seqstart = pairtok < 16384 ? (pairtok & ~8191) : 16384 + ((pairtok - 16384) & ~4095);
  const int segt = ((pairtok - seqstart) >> 8) + hh;
  const int nseg = S >> 8;
  const int segstart = seqstart + segt * 256;
  const int gseg0 = seqstart >> 8;
  float xr0 = 0.f, xi0 = 0.f, xr1 = 0.f, xi1 = 0.f;
  if (MODE != 0) {
    float pr0 = P.lbr[0], pi0 = P.lbi[0], pr1 = P.lbr[1], pi1 = P.lbi[1];
#pragma unroll
    for (int q = 0; q < 8; ++q) {
      float a = pr0 * pr0 - pi0 * pi0, b = 2.f * pr0 * pi0; pr0 = a; pi0 = b;
      float c = pr1 * pr1 - pi1 * pi1, dd = 2.f * pr1 * pi1; pr1 = c; pi1 = dd;
    }
    const float4* eb = ENDS + ((size_t)(dir * 64 + g) * 128) * 32;
    int cnt = dir == 0 ? segt : (nseg - 1 - segt);
    for (int c = 0; c < cnt; ++c) {
      int sg = dir == 0 ? c : (nseg - 1 - c);
      float4 e = eb[(size_t)(gseg0 + sg) * 32 + n];
      float a = pr0 * xr0 - pi0 * xi0 + e.x, b = pr0 * xi0 + pi0 * xr0 + e.y;
      xr0 = a; xi0 = b;
      float c2 = pr1 * xr1 - pi1 * xi1 + e.z, d2 = pr1 * xi1 + pi1 * xr1 + e.w;
      xr1 = c2; xi1 = d2;
    }
  }
  const int am = lane & 31;
  const int ahalf = (am >> 2) & 1, astep = ((am >> 3) << 2) | (am & 3);
  const int asegstart = seqstart + (((pairtok - seqstart) >> 8) + ahalf) * 256;
  const h16* ubase = U + g * 16 + 8 * (lane >> 5);
  auto utok = [&](int ci) { int tau = ci * 16 + astep; return dir ? (asegstart + 255 - tau) : (asegstart + tau); };
  half8 unext = *(const half8*)(ubase + (size_t)utok(0) * 1024);
  for (int ci = 0; ci < 16; ++ci) {
    half8 ua = unext;
    if (ci + 1 < 16) unext = *(const half8*)(ubase + (size_t)utok(ci + 1) * 1024);
    const int trow = lane & 15, qd = lane >> 4;
    half4 uo[2]; unsigned yp[2][2];
    if (MODE == 2) {
#pragma unroll
      for (int h2 = 0; h2 < 2; ++h2) {
        int sst = seqstart + (((pairtok - seqstart) >> 8) + h2) * 256;
        int tau = ci * 16 + trow;
        int tok = dir ? (sst + 255 - tau) : (sst + tau);
        const size_t off = (size_t)tok * 1024 + g * 16 + 4 * qd;
        uo[h2] = *(const half4*)(U + off);
        yp[h2][0] = __hip_atomic_load((unsigned*)(Y + off), __ATOMIC_RELAXED, __HIP_MEMORY_SCOPE_AGENT);
        yp[h2][1] = __hip_atomic_load((unsigned*)(Y + off) + 1, __ATOMIC_RELAXED, __HIP_MEMORY_SCOPE_AGENT);
      }
    }
    f32x16 bu[4];
#pragma unroll
    for (int nb = 0; nb < 4; ++nb) {
      f32x16 z;
#pragma unroll
      for (int i = 0; i < 16; ++i) z[i] = 0.f;
      bu[nb] = MFMA32(ua, P.Bop[nb], z);
    }
#pragma unroll
    for (int i = 0; i < 16; ++i) {
      float a = afma(P.lbr[0], xr0, afma(P.nlbi[0], xi0, bu[0][i]));
      float b = afma(P.lbr[0], xi0, afma(P.lbi[0], xr0, bu[1][i]));
      xr0 = a; xi0 = b;
      float c = afma(P.lbr[1], xr1, afma(P.nlbi[1], xi1, bu[2][i]));
      float dd = afma(P.lbr[1], xi1, afma(P.lbi[1], xr1, bu[3][i]));
      xr1 = c; xi1 = dd;
      asm volatile("" : "+v"(xr0), "+v"(xi0), "+v"(xr1), "+v"(xi1));
      if (MODE != 0) {
        half4 hv = {(h16)xr0, (h16)xi0, (h16)xr1, (h16)xi1};
        *(half4*)(X + (hh * 16 + i) * XROW + 4 * n) = hv;
      }
    }
    if (MODE != 0) {
      asm volatile("s_waitcnt lgkmcnt(0)" ::: "memory");
#pragma unroll
      for (int h2 = 0; h2 < 2; ++h2) {
        f32x4 y = {0.f, 0.f, 0.f, 0.f};
#pragma unroll
        for (int kb = 0; kb < 4; ++kb) {
          half8 xb = *(const half8*)(X + (h2 * 16 + trow) * XROW + 32 * kb + 8 * qd);
          y = MFMA16(P.Cop[kb], xb, y);
        }
        int sst = seqstart + (((pairtok - seqstart) >> 8) + h2) * 256;
        int tau = ci * 16 + trow;
        int tok = dir ? (sst + 255 - tau) : (sst + tau);
        h16* dst = Y + (size_t)tok * 1024 + g * 16 + 4 * qd;
        if (MODE == 1) {
          half4 o = {(h16)(y[0] * P.dt), (h16)(y[1] * P.dt), (h16)(y[2] * P.dt), (h16)(y[3] * P.dt)};
          *(half4*)dst = o;
        } else {
          union { unsigned w[2]; half4 h; } cv; cv.w[0] = yp[h2][0]; cv.w[1] = yp[h2][1];
          half4 o;
#pragma unroll
          for (int k = 0; k < 4; ++k) o[k] = (h16)gelu_tanh(dsk[k] * (float)uo[h2][k] + (float)cv.h[k] + y[k] * P.dt);
          *(half4*)dst = o;
        }
      }
      asm volatile("s_waitcnt lgkmcnt(0)" ::: "memory");
    }
  }
  if (MODE == 0) ENDS[((size_t)(dir * 64 + g) * 128 + (segstart >> 8)) * 32 + n] = make_float4(xr0, xi0, xr1, xi1);
}
__device__ __forceinline__ void phase_scan1(const Params& p, int j, char* smem) {
  const int tid = otid(), lane = tid & 63, wave = tid >> 6;
  const int nwaves = ogdim() * 8;
  const int wpc = nwaves >> 7;
  const int wglob = obid() * 8 + wave;
  if (wglob < wpc * 128) {
    const int combo = wglob & 127, slot = wglob >> 7;
    const int dir = combo & 1, g = combo >> 1;
    ScanPar P; scan_setup(p, j, dir, g, lane, false, P);
    const f32x4 dz = {0.f, 0.f, 0.f, 0.f};
    for (int sp = slot; sp < 64; sp += wpc) scan_run<0>(p, P, dir, g, sp, lane, (h16*)smem, dz);
  }
}
__device__ __forceinline__ void phase_scan2(const Params& p, int j, char* smem) {
  const int tid = otid(), lane = tid & 63, wave = tid >> 6;
  h16* X = (h16*)smem + wave * 32 * 136;
  const int nwaves = ogdim() * 8;
  const int wpg = nwaves >> 6;
  const int wglob = obid() * 8 + wave;
  if (wglob < wpg * 64) {
    const int g = wglob & 63, slot = wglob >> 6;
    ScanPar P0, P1;
    scan_setup(p, j, 0, g, lane, true, P0);
    scan_setup(p, j, 1, g, lane, true, P1);
    const f32x4 dsk = *(const f32x4*)(p.ssm_d + j * 1024 + g * 16 + 4 * (lane >> 4));
    for (int sp = slot; sp < 64; sp += wpg) {
      scan_run<1>(p, P0, 0, g, sp, lane, X, dsk);
      asm volatile("s_waitcnt vmcnt(0)" ::: "memory");
      scan_run<2>(p, P1, 1, g, sp, lane, X, dsk);
    }
  }
}

#define XB_TMO      128
#define XB_XCNT(j)  (256  + 64 * (j))
#define XB_XSUB(j)  (1280 + 64 * (j))
#define XB_XGEN(j)  (2304 + 64 * (j))
#define XB_TOP      3328
#define XB_TOPGEN   3392
#define XCD_BAR_WORDS 3456
#define XB_SPIN_CAP (1u << 22)
__device__ __forceinline__ unsigned xb_ld(unsigned* p)              { return __hip_atomic_load(p, __ATOMIC_RELAXED, __HIP_MEMORY_SCOPE_AGENT); }
__device__ __forceinline__ unsigned xb_add(unsigned* p, unsigned v) { return __hip_atomic_fetch_add(p, v, __ATOMIC_RELAXED, __HIP_MEMORY_SCOPE_AGENT); }
__device__ __forceinline__ unsigned xb_xcc_id() { return (unsigned)__builtin_amdgcn_s_getreg((3 << 11) | 20) & 0xFu; }
#define XB_SPIN(cond, bar) do { unsigned _sp = 0; while (cond) { __builtin_amdgcn_s_sleep(1); \
    if ((++_sp & 255u) == 0u) { if (xb_ld(&(bar)[XB_TMO])) break; if (_sp > XB_SPIN_CAP) { atomicAdd(&(bar)[XB_TMO], 1u); break; } } } } while (0)
struct XcdBarrier { unsigned* bar; unsigned x; volatile LAS unsigned* st; };
__device__ __forceinline__ XcdBarrier xcd_barrier_post(unsigned* bar, volatile LAS unsigned* st) {
  XcdBarrier b; b.bar = bar; b.x = xb_xcc_id(); b.st = st;
  if (threadIdx.x == 0) (void)xb_add(&bar[XB_XCNT(b.x)], 1u);
  return b;
}
__device__ __forceinline__ void xcd_barrier_complete(unsigned* bar, unsigned x, unsigned& nloc, unsigned& nx) {
  const unsigned G = gridDim.x * gridDim.y * gridDim.z;
  unsigned sum, cnt, mine, sp = 0u;
  for (;;) {
    sum = 0u; cnt = 0u; mine = 0u;
#pragma unroll
    for (unsigned j = 0; j < 16; ++j) { const unsigned c = xb_ld(&bar[XB_XCNT(j)]); sum += c; cnt += (c > 0u) ? 1u : 0u; mine = (j == x) ? c : mine; }
    if (sum == G) break;
    __builtin_amdgcn_s_sleep(1);
    if ((++sp & 255u) == 0u) { if (xb_ld(&bar[XB_TMO])) break; if (sp > XB_SPIN_CAP) { atomicAdd(&bar[XB_TMO], 1u); break; } }
  }
  nloc = mine > 0u ? mine : 1u; nx = cnt > 0u ? cnt : 1u;
}
__device__ __forceinline__ void xcd_barrier(const XcdBarrier& b) {
  asm volatile("s_waitcnt vmcnt(0)" ::: "memory");
  __syncthreads();
  if (threadIdx.x == 0) {
    unsigned* bar = b.bar;
    __builtin_amdgcn_s_waitcnt(0);
    unsigned nloc = b.st[0], nx = b.st[1];
    if (nloc == 0u) { xcd_barrier_complete(bar, b.x, nloc, nx); b.st[0] = nloc; b.st[1] = nx; }
    const unsigned old = xb_add(&bar[XB_XSUB(b.x)], 1u);
    const unsigned gen = old / nloc;
    if (old + 1u == (gen + 1u) * nloc) {
      __builtin_amdgcn_fence(__ATOMIC_RELEASE, "agent");
      asm volatile("s_waitcnt vmcnt(0)" ::: "memory");
      const unsigned og = xb_add(&bar[XB_TOP], 1u);
      const unsigned tg = og / nx;
      if (og + 1u == (tg + 1u) * nx) xb_add(&bar[XB_TOPGEN], 1u);
      else XB_SPIN(xb_ld(&bar[XB_TOPGEN]) == tg, bar);
      __builtin_amdgcn_fence(__ATOMIC_ACQUIRE, "agent");
      xb_add(&bar[XB_XGEN(b.x)], 1u);
      asm volatile("s_waitcnt vmcnt(0)" ::: "memory");
    } else {
      XB_SPIN(xb_ld(&bar[XB_XGEN(b.x)]) == gen, bar);
      __builtin_amdgcn_fence(__ATOMIC_ACQUIRE, "agent");
      asm volatile("s_waitcnt vmcnt(0)" ::: "memory");
    }
  }
  __syncthreads();
}

#ifndef PROBE_DUP
#define PROBE_DUP 0
#endif
#define SYNC() do { XcdBarrier xb_; xb_.bar = (unsigned*)(p.ws + OFF_BAR); xb_.x = xb_xcc_id(); xb_.st = (volatile LAS unsigned*)(smem + 147456); xcd_barrier(xb_); } while (0)
__global__ void __launch_bounds__(NT, 2) mega(Params p) {
  extern __shared__ __attribute__((aligned(16))) char smem[];
  if (p.ws == nullptr) cg::this_grid().sync();
  if (threadIdx.x == 0) *(uint4*)(smem + 147456) = make_uint4(0u, 0u, 0u, 0u);
  __syncthreads();
  (void)xcd_barrier_post((unsigned*)(p.ws + OFF_BAR), (volatile LAS unsigned*)(smem + 147456));
  phase0(p, smem);
  SYNC();
  for (int layer = 0; layer < 4; ++layer) {
    phase_norm(p, layer, smem);
    SYNC();
    if (PROBE_DUP & 32) { phase_norm(p, layer, smem); SYNC(); }
    if ((layer & 1) == 0) {
      for (int chunk = 0; chunk < 4; ++chunk) {
        phase_attn_in(p, chunk, smem);
        SYNC();
        if (PROBE_DUP & 16) { phase_attn_in(p, chunk, smem); SYNC(); }
        phase_attn(p, chunk, smem);
        SYNC();
        if (PROBE_DUP & 1) { phase_attn(p, chunk, smem); SYNC(); }
        phase_attn_combine(p, chunk);
        SYNC();
        if (PROBE_DUP & 64) { phase_attn_combine(p, chunk); SYNC(); }
      }
      phase_out_gemm(p, layer, p.ws + OFF_R0, p.ws + OFF_W + WA_OUT * 2, smem);
      SYNC();
    } else {
      int j = layer >> 1;
      phase_ssm_in(p, smem);
      SYNC();
      phase_scan1(p, j, smem);
      SYNC();
      phase_scan2(p, j, smem);
      SYNC();
      phase_ssm_glu(p, smem);
      SYNC();
      if (PROBE_DUP & 128) { phase_ssm_glu(p, smem); SYNC(); }
      phase_out_gemm(p, layer, p.ws + OFF_R1, p.ws + OFF_W + WS_OUT * 2, smem);
      SYNC();
    }
  }
  phase_final_norm(p);
}

extern "C" void kernel_launch(void* const* d_in, const int* in_sizes, int n_in, void* d_out, int out_size,
                              void* d_ws, size_t ws_size, hipStream_t stream) {
  static int grid_blocks = 0;
  if (!grid_blocks) {
    int dev = 0, cus = 0, per_cu = 0;
    hipGetDevice(&dev);
    hipDeviceGetAttribute(&cus, hipDeviceAttributeMultiprocessorCount, dev);
    hipFuncSetAttribute((const void*)mega, hipFuncAttributeMaxDynamicSharedMemorySize, SMEM_BYTES);
    hipOccupancyMaxActiveBlocksPerMultiprocessor(&per_cu, mega, NT, SMEM_BYTES);
    (void)hipGetLastError();
    grid_blocks = cus;
  }
  Params p{};
  p.x_prompt = (const float*)d_in[0]; p.x_sample = (const float*)d_in[1];
  p.c_prompt = (const float*)d_in[2]; p.c_sample = (const float*)d_in[3];
  p.norm_g = (const float*)d_in[4]; p.ada_w = (const float*)d_in[5]; p.ada_b = (const float*)d_in[6];
  p.attn_w_in = (const float*)d_in[7]; p.attn_w_out = (const float*)d_in[8]; p.ssm_w_in = (const float*)d_in[9];
  p.lam_re = (const float*)d_in[10]; p.lam_im = (const float*)d_in[11]; p.log_dt = (const float*)d_in[12];
  p.b_re = (const float*)d_in[13]; p.b_im = (const float*)d_in[14]; p.c_re = (const float*)d_in[15]; p.c_im = (const float*)d_in[16];
  p.ssm_d = (const float*)d_in[17]; p.w_glu = (const float*)d_in[18]; p.w_out = (const float*)d_in[19]; p.final_g = (const float*)d_in[20];
  p.out = (float*)d_out;
  p.ws = (char*)d_ws;
  hipMemsetAsync((char*)d_ws + OFF_BAR, 0, XCD_BAR_WORDS * sizeof(unsigned), stream);
  void* args[] = {&p};
  hipError_t e = hipLaunchCooperativeKernel((void*)mega, dim3(grid_blocks), dim3(NT), args, SMEM_BYTES, stream);
  if (e != hipSuccess) fprintf(stderr, "coop launch failed: %s (grid %d)\n", hipGetErrorString(e), grid_blocks);
}
```

```cpp
#include <hip/hip_runtime.h>
#include <hip/hip_cooperative_groups.h>
#include <cstdio>
#include <cstdint>
namespace cg = cooperative_groups;

typedef _Float16 h16;
typedef _Float16 half8 __attribute__((ext_vector_type(8)));
typedef _Float16 half4 __attribute__((ext_vector_type(4)));
typedef float f32x16 __attribute__((ext_vector_type(16)));
typedef float f32x4 __attribute__((ext_vector_type(4)));

#define NT 512
#define LAS __attribute__((address_space(3)))
#define MFMA32(a, b, c) __builtin_amdgcn_mfma_f32_32x32x16_f16(a, b, c, 0, 0, 0)
#define MFMA16(a, b, c) __builtin_amdgcn_mfma_f32_16x16x32_f16(a, b, c, 0, 0, 0)

constexpr int D = 1024;
constexpr int NTOK = 32768;
constexpr size_t MiB = 1024 * 1024;
constexpr size_t OFF_W = 0;
constexpr size_t OFF_ROPE = 24 * MiB;
constexpr size_t OFF_ADA = 26 * MiB;
constexpr size_t OFF_LSE = 27 * MiB;
constexpr size_t OFF_ENDS = 30 * MiB;
constexpr size_t OFF_BAR = 38 * MiB;
constexpr size_t OFF_R0 = 40 * MiB;
constexpr size_t OFF_BIG = 104 * MiB;
constexpr size_t OFF_QK = OFF_BIG;
constexpr size_t OFF_VT = OFF_BIG + 96 * MiB;
constexpr size_t OFF_ZC = OFF_BIG + 144 * MiB;
constexpr size_t OFF_O3 = OFF_BIG + 160 * MiB;
constexpr size_t OFF_R1 = OFF_BIG;
constexpr size_t OFF_R2 = OFF_BIG + 64 * MiB;
constexpr size_t OFF_R3 = OFF_BIG + 128 * MiB;
constexpr size_t WA_IN = 0;
constexpr size_t WA_OUT = (size_t)10240 * 1024;
constexpr size_t WS_IN = 0;
constexpr size_t WS_GLU = (size_t)2048 * 1024;
constexpr size_t WS_OUT = (size_t)3072 * 1024;

constexpr int ATT_LDS = 70656;
constexpr int SMEM_BYTES = 147456 + 16;

struct Params {
  const float *x_prompt, *x_sample, *c_prompt, *c_sample, *norm_g, *ada_w, *ada_b, *attn_w_in, *attn_w_out,
      *ssm_w_in, *lam_re, *lam_im, *log_dt, *b_re, *b_im, *c_re, *c_im, *ssm_d, *w_glu, *w_out, *final_g;
  float* out;
  char* ws;
};

__device__ __forceinline__ int otid() { int t = threadIdx.x; asm volatile("" : "+v"(t)); return t; }
__device__ __forceinline__ float afma(float a, float b, float c) { return __builtin_fmaf(a, b, c); }
__device__ __forceinline__ half8 pack8(f32x4 a, f32x4 b) { half8 o = {(h16)a[0], (h16)a[1], (h16)a[2], (h16)a[3], (h16)b[0], (h16)b[1], (h16)b[2], (h16)b[3]}; return o; }
__device__ __forceinline__ int obid() { int b = blockIdx.x; asm volatile("" : "+s"(b)); return b; }
__device__ __forceinline__ int ogdim() { int b = gridDim.x; asm volatile("" : "+s"(b)); return b; }
__device__ __forceinline__ half8 zero8() { float z = 0.f; asm volatile("" : "+v"(z)); f32x4 t = {z, z, z, z}; return __builtin_bit_cast(half8, t); }
__device__ __forceinline__ float shx(float v, int mask, int lane) { return __int_as_float(__builtin_amdgcn_ds_bpermute((lane ^ mask) << 2, __float_as_int(v))); }
__device__ __forceinline__ int seq_of_tok(int t) { return t < 16384 ? (t >> 13) : 2 + ((t - 16384) >> 12); }
__device__ __forceinline__ float silu_f(float x) { return x * __builtin_amdgcn_rcpf(1.f + __expf(-x)); }
__device__ __forceinline__ float sigmoid_f(float x) { return __builtin_amdgcn_rcpf(1.f + __expf(-x)); }
__device__ __forceinline__ float gelu_tanh(float x) {
  float u = 0.7978845608028654f * (x + 0.044715f * x * x * x);
  float t = 1.f - 2.f * __builtin_amdgcn_rcpf(1.f + __expf(2.f * u));
  return 0.5f * x * (1.f + t);
}

__device__ __forceinline__ void sincos_acc(float angf, float& s, float& c) {
  double a = (double)angf;
  double kd = rint(a * 0.6366197723675814);
  double r = a - kd * 1.5707963267948966 - kd * 6.123233995736766e-17;
  int k = ((int)kd) & 3;
  double r2 = r * r;
  double sp = r * (1.0 + r2 * (-1.0 / 6 + r2 * (1.0 / 120 + r2 * (-1.0 / 5040 + r2 * (1.0 / 362880 + r2 * (-1.0 / 39916800 + r2 * (1.0 / 6227020800.0)))))));
  double cp = 1.0 + r2 * (-0.5 + r2 * (1.0 / 24 + r2 * (-1.0 / 720 + r2 * (1.0 / 40320 + r2 * (-1.0 / 3628800 + r2 * (1.0 / 479001600 + r2 * (-1.0 / 87178291200.0)))))));
  double ss = (k & 1) ? cp : sp;
  double cc = (k & 1) ? sp : cp;
  if (k == 1) cc = -cc;
  if (k == 2) { ss = -ss; cc = -cc; }
  if (k == 3) ss = -ss;
  s = (float)ss;
  c = (float)cc;
}

__device__ __forceinline__ void convert_tile(const float* __restrict__ src, h16* __restrict__ dst, int N, int tile, char* smem) {
  float(*t)[129] = (float(*)[129])smem;
  const int ctid = otid();
  int ntn = N >> 7;
  int k0 = (tile / ntn) << 6, n0 = (tile % ntn) << 7;
  int tx = ctid & 31, ty = ctid >> 5;
#pragma unroll
  for (int i = 0; i < 4; ++i) {
    int k = ty + 16 * i;
    float4 v = *(const float4*)(src + (size_t)(k0 + k) * N + n0 + 4 * tx);
    t[k][4 * tx + 0] = v.x; t[k][4 * tx + 1] = v.y; t[k][4 * tx + 2] = v.z; t[k][4 * tx + 3] = v.w;
  }
  __syncthreads();
#pragma unroll
  for (int i = 0; i < 2; ++i) {
    int idx = ctid + 512 * i;
    int nn = idx >> 3, kc = idx & 7;
    half8 o;
#pragma unroll
    for (int j = 0; j < 8; ++j) o[j] = (h16)t[kc * 8 + j][nn];
    *(half8*)(dst + (size_t)(n0 + nn) * 1024 + k0 + kc * 8) = o;
  }
  __syncthreads();
}

__device__ __forceinline__ void convert_layer_weights(const Params& p, int layer, int item0, int nitems_before, char* smem) {
  h16* W = (h16*)(p.ws + OFF_W);
  int j = layer >> 1;
  if ((layer & 1) == 0) {
    const int n_in = 16 * 80, n_out = 128;
    for (int it = item0; it < nitems_before + n_in + n_out; it += ogdim()) {
      int t = it - nitems_before;
      if (t < 0) continue;
      if (t < n_in) convert_tile(p.attn_w_in + (size_t)j * 1024 * 10240, W + WA_IN, 10240, t, smem);
      else convert_tile(p.attn_w_out + (size_t)j * 1024 * 1024, W + WA_OUT, 1024, t - n_in, smem);
    }
  } else {
    const int n_in = 16 * 16, n_g = 128, n_o = 128;
    for (int it = item0; it < nitems_before + n_in + n_g + n_o; it += ogdim()) {
      int t = it - nitems_before;
      if (t < 0) continue;
      if (t < n_in) convert_tile(p.ssm_w_in + (size_t)j * 1024 * 2048, W + WS_IN, 2048, t, smem);
      else if (t < n_in + n_g) convert_tile(p.w_glu + (size_t)j * 1024 * 1024, W + WS_GLU, 1024, t - n_in, smem);
      else convert_tile(p.w_out + (size_t)j * 1024 * 1024, W + WS_OUT, 1024, t - n_in - n_g, smem);
    }
  }
}

__device__ __forceinline__ void phase0(const Params& p, char* smem) {
  const int tid = otid(); const int lane = tid & 63, wave = tid >> 6;
  const int N_ADA = 192, N_ROPE = 512;
  float* ADA = (float*)(p.ws + OFF_ADA);
  float2* ROPE = (float2*)(p.ws + OFF_ROPE);
  int it = obid();
  for (; it < N_ADA; it += ogdim()) {
    int layer = it / 48, cb = it % 48;
    float* sc = (float*)smem;
    float* red = (float*)(smem + 6 * 1024 * 4);
    for (int i = tid; i < 6144; i += NT) {
      int s = i >> 10, k = i & 1023;
      float c = s < 2 ? p.c_prompt[s * 1024 + k] : p.c_sample[(s - 2) * 1024 + k];
      sc[i] = silu_f(c);
    }
    __syncthreads();
    int col = cb * 64 + lane;
    float acc[6] = {0.f, 0.f, 0.f, 0.f, 0.f, 0.f};
    const float* wp = p.ada_w + ((size_t)layer * 1024 + wave * 128) * 3072 + col;
#pragma unroll 8
    for (int k = 0; k < 128; ++k) {
      float wv = wp[(size_t)k * 3072];
#pragma unroll
      for (int s = 0; s < 6; ++s) acc[s] += sc[s * 1024 + wave * 128 + k] * wv;
    }
#pragma unroll
    for (int s = 0; s < 6; ++s) red[(wave * 6 + s) * 64 + lane] = acc[s];
    __syncthreads();
    if (wave == 0) {
#pragma unroll
      for (int s = 0; s < 6; ++s) {
        float v = 0.f;
#pragma unroll
        for (int w8 = 0; w8 < 8; ++w8) v += red[(w8 * 6 + s) * 64 + lane];
        ADA[(layer * 6 + s) * 3072 + col] = v + p.ada_b[layer * 3072 + col];
      }
    }
    __syncthreads();
  }
  for (; it < N_ADA + N_ROPE; it += ogdim()) {
    int idx = (it - N_ADA) * NT + tid;
    int pos = idx >> 5, e = idx & 31;
    float invf = (float)exp(-(double)(2 * e) / 64.0 * 9.210340371976184);
    float ang = (float)pos * invf;
    float s, c;
    sincos_acc(ang, s, c);
    ROPE[idx] = make_float2(c, s);
  }
  convert_layer_weights(p, 0, it, N_ADA + N_ROPE, smem);
}

__device__ __forceinline__ void phase_norm(const Params& p, int layer, char* smem) {
  const int tid = otid(); const int lane = tid & 63, wave = tid >> 6;
  h16* H = (h16*)(p.ws + OFF_R0);
  const float* ADA = (const float*)(p.ws + OFF_ADA);
  const float* g = p.norm_g + layer * 1024;
  int it = obid();
  if (layer == 0) {
    auto rowptr = [&](int row) -> const float4* { return (const float4*)(row < 16384 ? p.x_prompt + (size_t)row * 1024 : p.x_sample + (size_t)(row - 16384) * 1024); };
    float4 gg[4], sh[4], scl[4];
#pragma unroll
    for (int j = 0; j < 4; ++j) gg[j] = *(const float4*)(g + 4 * (lane + 64 * j));
    int cur_seq = -1;
    float4 vn[4];
    if (it < NTOK / 8) {
      const float4* xr = rowptr(it * 8 + wave);
#pragma unroll
      for (int j = 0; j < 4; ++j) vn[j] = xr[lane + 64 * j];
    }
    for (; it < NTOK / 8; it += ogdim()) {
      const int row = it * 8 + wave;
      float4 v[4];
#pragma unroll
      for (int j = 0; j < 4; ++j) v[j] = vn[j];
      const int itn = it + ogdim();
      if (itn < NTOK / 8) {
        const float4* xr = rowptr(itn * 8 + wave);
#pragma unroll
        for (int j = 0; j < 4; ++j) vn[j] = xr[lane + 64 * j];
      }
      const int seq = seq_of_tok(row);
      if (seq != cur_seq) {
        cur_seq = seq;
        const float* ada = ADA + (layer * 6 + seq) * 3072;
#pragma unroll
        for (int j = 0; j < 4; ++j) { sh[j] = *(const float4*)(ada + 4 * (lane + 64 * j)); scl[j] = *(const float4*)(ada + 1024 + 4 * (lane + 64 * j)); }
      }
      float ss = 0.f;
#pragma unroll
      for (int j = 0; j < 4; ++j) ss += v[j].x * v[j].x + v[j].y * v[j].y + v[j].z * v[j].z + v[j].w * v[j].w;
#pragma unroll
      for (int o = 32; o >= 1; o >>= 1) ss += shx(ss, o, lane);
      float rstd = rsqrtf(ss * (1.f / 1024.f) + 1e-6f);
#pragma unroll
      for (int j = 0; j < 4; ++j) {
        int idx = 4 * (lane + 64 * j);
        half4 o;
        o[0] = (h16)(v[j].x * rstd * gg[j].x * (1.f + scl[j].x) + sh[j].x);
        o[1] = (h16)(v[j].y * rstd * gg[j].y * (1.f + scl[j].y) + sh[j].y);
        o[2] = (h16)(v[j].z * rstd * gg[j].z * (1.f + scl[j].z) + sh[j].z);
        o[3] = (h16)(v[j].w * rstd * gg[j].w * (1.f + scl[j].w) + sh[j].w);
        *(half4*)(H + (size_t)row * 1024 + idx) = o;
      }
    }
  } else {
    const h16* X16 = (const h16*)p.out;
    f32x4 gg[2][2], sh[2][2], scl[2][2];
#pragma unroll
    for (int j = 0; j < 2; ++j)
#pragma unroll
      for (int n = 0; n < 2; ++n) gg[j][n] = *(const f32x4*)(g + 8 * (lane + 64 * j) + 4 * n);
    int cur_seq = -1;
    half8 vn[2];
    if (it < NTOK / 8) {
#pragma unroll
      for (int j = 0; j < 2; ++j) vn[j] = *(const half8*)(X16 + (size_t)(it * 8 + wave) * 1024 + 8 * (lane + 64 * j));
    }
    for (; it < NTOK / 8; it += ogdim()) {
      const int row = it * 8 + wave;
      half8 v[2];
#pragma unroll
      for (int j = 0; j < 2; ++j) v[j] = vn[j];
      const int itn = it + ogdim();
      if (itn < NTOK / 8) {
#pragma unroll
        for (int j = 0; j < 2; ++j) vn[j] = *(const half8*)(X16 + (size_t)(itn * 8 + wave) * 1024 + 8 * (lane + 64 * j));
      }
      const int seq = seq_of_tok(row);
      if (seq != cur_seq) {
        cur_seq = seq;
        const float* ada = ADA + (layer * 6 + seq) * 3072;
#pragma unroll
        for (int j = 0; j < 2; ++j)
#pragma unroll
          for (int n = 0; n < 2; ++n) { sh[j][n] = *(const f32x4*)(ada + 8 * (lane + 64 * j) + 4 * n); scl[j][n] = *(const f32x4*)(ada + 1024 + 8 * (lane + 64 * j) + 4 * n); }
      }
      f32x4 f[2][2];
      float ss = 0.f;
#pragma unroll
      for (int j = 0; j < 2; ++j)
#pragma unroll
        for (int n = 0; n < 2; ++n)
#pragma unroll
          for (int k = 0; k < 4; ++k) { const float t = (float)v[j][4 * n + k]; f[j][n][k] = t; ss += t * t; }
#pragma unroll
      for (int o = 32; o >= 1; o >>= 1) ss += shx(ss, o, lane);
      const float rstd = rsqrtf(ss * (1.f / 1024.f) + 1e-6f);
#pragma unroll
      for (int j = 0; j < 2; ++j) {
        const f32x4 lo = f[j][0] * rstd * gg[j][0] * (scl[j][0] + 1.f) + sh[j][0];
        const f32x4 hi = f[j][1] * rstd * gg[j][1] * (scl[j][1] + 1.f) + sh[j][1];
        *(half8*)(H + (size_t)row * 1024 + 8 * (lane + 64 * j)) = pack8(lo, hi);
      }
    }
  }
  if (layer > 0) convert_layer_weights(p, layer, it, NTOK / 8, smem);
}

__device__ __forceinline__ void phase_final_norm(const Params& p) {
  const int tid = otid(); const int lane = tid & 63, wave = tid >> 6;
  const h16* X16 = (const h16*)(p.ws + OFF_R3);
  f32x4 gg[2][2];
#pragma unroll
  for (int j = 0; j < 2; ++j)
#pragma unroll
    for (int n = 0; n < 2; ++n) gg[j][n] = *(const f32x4*)(p.final_g + 8 * (lane + 64 * j) + 4 * n);
  int it = obid();
  half8 vn[2];
  if (it < NTOK / 8) {
#pragma unroll
    for (int j = 0; j < 2; ++j) vn[j] = *(const half8*)(X16 + (size_t)(it * 8 + wave) * 1024 + 8 * (lane + 64 * j));
  }
  for (; it < NTOK / 8; it += ogdim()) {
    const int row = it * 8 + wave;
    half8 v[2];
#pragma unroll
    for (int j = 0; j < 2; ++j) v[j] = vn[j];
    const int itn = it + ogdim();
    if (itn < NTOK / 8) {
#pragma unroll
      for (int j = 0; j < 2; ++j) vn[j] = *(const half8*)(X16 + (size_t)(itn * 8 + wave) * 1024 + 8 * (lane + 64 * j));
    }
    f32x4 f[2][2];
    float ss = 0.f;
#pragma unroll
    for (int j = 0; j < 2; ++j)
#pragma unroll
      for (int n = 0; n < 2; ++n)
#pragma unroll
        for (int k = 0; k < 4; ++k) { const float t = (float)v[j][4 * n + k]; f[j][n][k] = t; ss += t * t; }
#pragma unroll
    for (int o = 32; o >= 1; o >>= 1) ss += shx(ss, o, lane);
    const float rstd = rsqrtf(ss * (1.f / 1024.f) + 1e-6f);
    float* xo = p.out + (size_t)row * 1024;
#pragma unroll
    for (int j = 0; j < 2; ++j)
#pragma unroll
      for (int n = 0; n < 2; ++n) *(f32x4*)(xo + 8 * (lane + 64 * j) + 4 * n) = f[j][n] * rstd * gg[j][n];
  }
}

namespace pg8 {
constexpr int BK = 64, HALF = 128, HTB = HALF * BK * 2, STAGE_BYTES = 8 * HTB;
enum { PK_NONE = 0, PK_P32 = 1, PK_ROPE = 2 };
__device__ __forceinline__ int lds_byte(int r, int c) { const int st = (r >> 4) * 2 + (c >> 5), rr = r & 15, cc = c & 31, ob = rr * 64 + cc * 2; return st * 1024 + (ob ^ (((ob >> 9) & 1) << 5)); }
__device__ __forceinline__ void stage_rc(int b, int& R, int& C) { const int st = b / 1024, sb = b % 1024, swz = sb ^ (((sb >> 9) & 1) << 5); R = (st >> 1) * 16 + swz / 64; C = (st & 1) * 32 + (swz % 64) / 2; }
__device__ __forceinline__ int perm_row(int R, int kind) {
  if (kind == PK_P32) { const int rho = R & 31, n = rho >> 4, i = rho & 15; return (R & ~31) + 8 * (i >> 2) + 4 * n + (i & 3); }
  if (kind == PK_ROPE) { const int rho = R & 31, n = rho >> 4, i = rho & 15; return 2 * (R & ~31) + 8 * (i >> 2) + 4 * n + (i & 3); }
  return R;
}
struct Unit { const char* A; const char* B; unsigned ldb; int pkind; int kind; int pm; int pn; int aux; };
__device__ __forceinline__ void tile_of(int L, int nM, int nN, int& pm, int& pn) {
  const int nwg = nM * nN; int wgid = L;
  { const int q = nwg / 8, r = nwg % 8, xcd = wgid % 8, off = wgid / 8; wgid = (xcd < r ? xcd * (q + 1) : r * (q + 1) + (xcd - r) * q) + off; }
  const int nig = 8 * nN, gid = wgid / nig, fm = gid * 8, gsz = (nM - fm) < 8 ? (nM - fm) : 8;
  pm = fm + ((wgid % nig) % gsz); pn = (wgid % nig) / gsz;
}

template <class Epi, class Sched>
__device__ __forceinline__ void gemm_phase(LAS unsigned char* lds, const Sched& S, const Epi& E, const int tid) {
  const int wid = __builtin_amdgcn_readfirstlane(tid >> 6), lane = tid & 63, wr = wid >> 2, wc = wid & 3, fr = lane & 15, fq = lane >> 4;
  constexpr int K = 1024, nt = K / BK;
  unsigned voffA[2];
#pragma unroll
  for (int i = 0; i < 2; ++i) { int sR, sC; stage_rc(tid * 16 + i * 8192, sR, sC); voffA[i] = (unsigned)(sR * K + sC) * 2u; }
  const size_t kstep = (size_t)(BK * 2);
  const size_t hstepA = (size_t)HALF * K * 2;
  const unsigned ldsw = (unsigned)wid * 1024u;
  const int aoff = lds_byte(wr * 64 + fr, fq * 8), boff = lds_byte(wc * 32 + fr, fq * 8);
#define PG8_SA(b, h) (((b) * 2 + (h)) * HTB)
#define PG8_SB(b, h) ((4 + (b) * 2 + (h)) * HTB)
#define PG8_STAGE(bufoff, gbase, voff) do { _Pragma("unroll") for (int _i = 0; _i < 2; ++_i) \
    __builtin_amdgcn_global_load_lds((const unsigned*)((const char*)(gbase) + (voff)[_i]), (LAS unsigned*)(lds + (bufoff) + ldsw + _i * 8192), 16, 0, 0); } while (0)
#define PG8_LDA(dst, b, h) do { _Pragma("unroll") for (int m = 0; m < 4; ++m) _Pragma("unroll") for (int k = 0; k < 2; ++k) dst[m][k] = *(const LAS half8*)(lds + PG8_SA(b, h) + aoff + m * 2048 + k * 1024); } while (0)
#define PG8_LDB(dst, b, h) do { _Pragma("unroll") for (int n = 0; n < 2; ++n) _Pragma("unroll") for (int k = 0; k < 2; ++k) dst[n][k] = *(const LAS half8*)(lds + PG8_SB(b, h) + boff + n * 2048 + k * 1024); } while (0)
#define PG8_MMA(ai, bj, At, Bt) do { __builtin_amdgcn_s_setprio(1); _Pragma("unroll") for (int m = 0; m < 4; ++m) _Pragma("unroll") for (int n = 0; n < 2; ++n) _Pragma("unroll") for (int k = 0; k < 2; ++k) \
    acc[ai][bj][m][n] = __builtin_amdgcn_mfma_f32_16x16x32_f16(Bt[n][k], At[m][k], acc[ai][bj][m][n], 0, 0, 0); __builtin_amdgcn_s_setprio(0); } while (0)
#define PG8_WAIT_V(n) asm volatile("s_waitcnt vmcnt(" #n ")" ::: "memory")
#define PG8_WAIT_L(n) asm volatile("s_waitcnt lgkmcnt(" #n ")" ::: "memory")
#define PG8_BAR __builtin_amdgcn_s_barrier()
#define PG8_SCHED __builtin_amdgcn_sched_barrier(0)
  Unit cur, nxt; int ui = 0;
  if (!S.next(0, cur)) return;
  f32x4 acc[2][2][4][2];
#pragma unroll
  for (int a = 0; a < 2; ++a)
#pragma unroll
    for (int b = 0; b < 2; ++b)
#pragma unroll
      for (int m = 0; m < 4; ++m)
#pragma unroll
        for (int n = 0; n < 2; ++n) acc[a][b][m][n] = (f32x4){0.f, 0.f, 0.f, 0.f};
  half8 At[4][2], B0[2][2], B1[2][2];
  const char* cA = cur.A; const char* cB = cur.B;
  unsigned vbc[2], vbn[2];
  size_t hBc = (size_t)(cur.pkind == PK_ROPE ? 32 : HALF) * cur.ldb, hBn;
#pragma unroll
  for (int i = 0; i < 2; ++i) { int sR, sC; stage_rc(tid * 16 + i * 8192, sR, sC); vbc[i] = (unsigned)perm_row(sR, cur.pkind) * cur.ldb + (unsigned)sC * 2u; }
  PG8_STAGE(PG8_SB(0, 0), cB, vbc); PG8_STAGE(PG8_SA(0, 0), cA, voffA); PG8_STAGE(PG8_SB(0, 1), cB + hBc, vbc); PG8_STAGE(PG8_SA(0, 1), cA + hstepA, voffA);
  if (wr == 1) PG8_BAR;
  PG8_WAIT_V(4); PG8_BAR;
  PG8_STAGE(PG8_SB(1, 0), cB + kstep, vbc); PG8_STAGE(PG8_SA(1, 0), cA + kstep, voffA); PG8_STAGE(PG8_SB(1, 1), cB + hBc + kstep, vbc);
  PG8_WAIT_V(6); PG8_BAR;
  for (;;) {
    const bool has_next = S.next(ui + 1, nxt);
    const char* nA = has_next ? nxt.A : cA; const char* nB = has_next ? nxt.B : cB;
    hBn = has_next ? (size_t)(nxt.pkind == PK_ROPE ? 32 : HALF) * nxt.ldb : hBc;
#pragma unroll
    for (int i = 0; i < 2; ++i) { int sR, sC; stage_rc(tid * 16 + i * 8192, sR, sC); vbn[i] = has_next ? ((unsigned)perm_row(sR, nxt.pkind) * nxt.ldb + (unsigned)sC * 2u) : vbc[i]; }
    for (int t = 0; t < nt; t += 2) {
      const bool last = (t == nt - 2);
      const char* a1 = cA + (size_t)(t + 1) * kstep;
      const char* a2 = last ? nA : cA + (size_t)(t + 2) * kstep; const char* b2 = last ? nB : cB + (size_t)(t + 2) * kstep;
      const char* a3 = a2 + kstep; const char* b3 = b2 + kstep;
      unsigned vb[2]; vb[0] = last ? vbn[0] : vbc[0]; vb[1] = last ? vbn[1] : vbc[1];
      const size_t hb = last ? hBn : hBc;
      const bool dostage = !(last && !has_next);
      PG8_LDB(B0, 0, 0); PG8_SCHED; PG8_LDA(At, 0, 0); PG8_STAGE(PG8_SA(1, 1), a1 + hstepA, voffA);
      PG8_WAIT_L(8); PG8_BAR; PG8_WAIT_L(0); PG8_MMA(0, 0, At, B0); PG8_BAR; PG8_SCHED;
      PG8_LDB(B1, 0, 1); if (dostage) PG8_STAGE(PG8_SB(0, 0), b2, vb);
      PG8_BAR; PG8_WAIT_L(0); PG8_MMA(0, 1, At, B1); PG8_BAR;
      PG8_LDA(At, 0, 1); if (dostage) PG8_STAGE(PG8_SA(0, 0), a2, voffA);
      PG8_BAR; PG8_WAIT_L(0); PG8_MMA(1, 0, At, B0); PG8_BAR; PG8_SCHED;
      if (dostage) { PG8_STAGE(PG8_SB(0, 1), b2 + hb, vb); PG8_WAIT_V(6); } else { PG8_WAIT_V(0); }
      PG8_BAR; PG8_MMA(1, 1, At, B1); PG8_BAR;
      PG8_LDB(B0, 1, 0); PG8_SCHED; PG8_LDA(At, 1, 0); if (dostage) PG8_STAGE(PG8_SA(0, 1), a2 + hstepA, voffA);
      PG8_WAIT_L(8); PG8_BAR; PG8_WAIT_L(0); PG8_MMA(0, 0, At, B0); PG8_BAR; PG8_SCHED;
      PG8_LDB(B1, 1, 1); if (dostage) PG8_STAGE(PG8_SB(1, 0), b3, vb);
      PG8_BAR; PG8_WAIT_L(0); PG8_MMA(0, 1, At, B1); PG8_BAR;
      PG8_LDA(At, 1, 1); if (dostage) PG8_STAGE(PG8_SA(1, 0), a3, voffA);
      PG8_BAR; PG8_WAIT_L(0); PG8_MMA(1, 0, At, B0); PG8_BAR; PG8_SCHED;
      if (dostage) { PG8_STAGE(PG8_SB(1, 1), b3 + hb, vb); PG8_WAIT_V(6); } else { PG8_WAIT_V(0); }
      PG8_BAR; PG8_MMA(1, 1, At, B1); PG8_BAR;
    }
    E(acc, cur, wr, wc, fr, fq);
    if (!has_next) break;
#pragma unroll
    for (int a = 0; a < 2; ++a)
#pragma unroll
      for (int b = 0; b < 2; ++b)
#pragma unroll
        for (int m = 0; m < 4; ++m)
#pragma unroll
          for (int n = 0; n < 2; ++n) acc[a][b][m][n] = (f32x4){0.f, 0.f, 0.f, 0.f};
    cur = nxt; cA = nA; cB = nB; hBc = hBn; vbc[0] = vbn[0]; vbc[1] = vbn[1]; ++ui;
  }
  PG8_WAIT_V(0);
  if (wr == 0) PG8_BAR;
  PG8_BAR;
#undef PG8_SA
#undef PG8_SB
#undef PG8_STAGE
#undef PG8_LDA
#undef PG8_LDB
#undef PG8_MMA
#undef PG8_WAIT_V
#undef PG8_WAIT_L
#undef PG8_BAR
#undef PG8_SCHED
}
}
typedef f32x4 acc_t[2][2][4][2];


enum { UK_QK = 0, UK_Z = 1, UK_VT = 2 };
struct AttnInSched {
  const char* H; const char* W; int tok0; int S;
  __device__ __forceinline__ bool next(int i, pg8::Unit& u) const {
    const int L = i * ogdim() + obid();
    if (L >= 1280) return false;
    if (L < 896) {
      int pm, pn; pg8::tile_of(L, 32, 28, pm, pn);
      u.pm = pm; u.ldb = 2048u;
      u.A = H + (size_t)(tok0 + pm * 256) * 2048;
      if (pn < 24) {
        const int g = pn >> 3, qk = (pn >> 2) & 1, cb = pn & 3;
        u.kind = UK_QK; u.pkind = pg8::PK_ROPE; u.pn = pn; u.aux = (g * 2 + qk) * 1024 + cb * 256;
        u.B = W + (size_t)(g * 3072 + qk * 1024 + cb * 256) * 2048;
      } else {
        u.kind = UK_Z; u.pkind = pg8::PK_P32; u.pn = pn - 24; u.aux = 0;
        u.B = W + (size_t)(9216 + (pn - 24) * 256) * 2048;
      }
    } else {
      int pm, pn; pg8::tile_of(L - 896, 12, 32, pm, pn);
      const int g = pm >> 2, fb = pm & 3;
      const int d = g == 0 ? 1 : (g == 1 ? 4 : 16);
      const int m = S / d;
      const int tp0 = pn * 256;
      const int sl = tp0 / S, w = tp0 % S, r = w / m, i0 = w % m;
      u.kind = UK_VT; u.pkind = pg8::PK_P32; u.pm = fb; u.pn = pn; u.aux = g;
      u.A = W + (size_t)(g * 3072 + 2048 + fb * 256) * 2048;
      u.B = H + (size_t)(tok0 + sl * S + i0 * d + r) * 2048;
      u.ldb = (unsigned)d * 2048u;
    }
    return true;
  }
};
struct AttnInEpi {
  h16* QK; h16* VT; h16* ZC; const float4* ROPE; int S;
  __device__ __forceinline__ void operator()(const acc_t& acc, const pg8::Unit& u, int wr, int wc, int fr, int fq) const {
    if (u.kind == UK_QK) {
      const float qs = ((u.aux >> 10) & 1) ? 1.f : 0.125f * 1.4426950408889634f;
      const int e0 = 8 * fq;
      const int tl0 = u.pm * 256 + wr * 64 + fr;
      const int ib = (((tl0) & (S - 1)) * 32 + e0) >> 1, ir = (16 * 32 + e0) >> 1;
      float c[8], sn[8], rc[8], rs[8];
#pragma unroll
      for (int k = 0; k < 4; ++k) {
        const float4 bv = ROPE[ib + k], rv = ROPE[ir + k];
        c[2 * k] = bv.x; sn[2 * k] = bv.y; c[2 * k + 1] = bv.z; sn[2 * k + 1] = bv.w;
        rc[2 * k] = rv.x; rs[2 * k] = rv.y; rc[2 * k + 1] = rv.z; rs[2 * k + 1] = rv.w;
      }
#pragma unroll
      for (int ai = 0; ai < 2; ++ai) {
#pragma unroll
        for (int m = 0; m < 4; ++m) {
          const int tl = tl0 + ai * 128 + m * 16;
          half8 o1, o2;
#pragma unroll
          for (int n = 0; n < 2; ++n) {
            const f32x4 t1 = acc[ai][0][m][n], t2 = acc[ai][1][m][n];
#pragma unroll
            for (int j = 0; j < 4; ++j) {
              o1[4 * n + j] = (h16)((t1[j] * c[4 * n + j] - t2[j] * sn[4 * n + j]) * qs);
              o2[4 * n + j] = (h16)((t2[j] * c[4 * n + j] + t1[j] * sn[4 * n + j]) * qs);
            }
          }
          h16* dst = QK + (size_t)tl * 6144 + u.aux + 64 * wc + e0;
          *(half8*)dst = o1;
          *(half8*)(dst + 32) = o2;
          const int nrot = (m < 3) ? 1 : (ai == 0 ? 5 : 0);
#pragma unroll
          for (int k = 0; k < nrot; ++k)
#pragma unroll
            for (int j = 0; j < 8; ++j) { const float cn = c[j] * rc[j] - sn[j] * rs[j], sx = sn[j] * rc[j] + c[j] * rs[j]; c[j] = cn; sn[j] = sx; }
        }
      }
    } else if (u.kind == UK_Z) {
#pragma unroll
      for (int ai = 0; ai < 2; ++ai)
#pragma unroll
        for (int m = 0; m < 4; ++m) {
          const int tl = u.pm * 256 + ai * 128 + wr * 64 + m * 16 + fr;
#pragma unroll
          for (int bj = 0; bj < 2; ++bj) {
            f32x4 a = acc[ai][bj][m][0], b = acc[ai][bj][m][1];
#pragma unroll
            for (int j = 0; j < 4; ++j) { a[j] = silu_f(a[j]); b[j] = silu_f(b[j]); }
            *(half8*)(ZC + (size_t)tl * 1024 + u.pn * 256 + bj * 128 + wc * 32 + 8 * fq) = pack8(a, b);
          }
        }
    } else {
#pragma unroll
      for (int ai = 0; ai < 2; ++ai)
#pragma unroll
        for (int m = 0; m < 4; ++m) {
          const int f = u.pm * 256 + ai * 128 + wr * 64 + m * 16 + fr;
#pragma unroll
          for (int bj = 0; bj < 2; ++bj)
            *(half8*)(VT + ((size_t)u.aux * 1024 + f) * 8192 + u.pn * 256 + bj * 128 + wc * 32 + 8 * fq) = pack8(acc[ai][bj][m][0], acc[ai][bj][m][1]);
        }
    }
  }
};
__device__ __forceinline__ void phase_attn_in(const Params& p, int chunk, char* smem) {
  const int tid = otid();
  AttnInSched S; S.H = p.ws + OFF_R0; S.W = p.ws + OFF_W + WA_IN * 2; S.tok0 = chunk * 8192; S.S = chunk < 2 ? 8192 : 4096;
  AttnInEpi E; E.QK = (h16*)(p.ws + OFF_QK); E.VT = (h16*)(p.ws + OFF_VT); E.ZC = (h16*)(p.ws + OFF_ZC); E.ROPE = (const float4*)(p.ws + OFF_ROPE); E.S = S.S;
  pg8::gemm_phase(( LAS unsigned char*)smem, S, E, tid);
}

struct PlainSched {
  const char* A; const char* W; int nN; int pkind;
  __device__ __forceinline__ bool next(int i, pg8::Unit& u) const {
    const int L = i * ogdim() + obid();
    if (L >= 128 * nN) return false;
    int pm, pn; pg8::tile_of(L, 128, nN, pm, pn);
    u.pm = pm; u.pn = pn; u.ldb = 2048u; u.kind = 0; u.pkind = pkind; u.aux = 0;
    u.A = A + (size_t)pm * 256 * 2048; u.B = W + (size_t)pn * 256 * 2048;
    return true;
  }
};
struct OutEpi {
  const float* xp; const float* xs; const h16* x16in; h16* x16out; const float* ADA; int layer;
  __device__ __forceinline__ void operator()(const acc_t& acc, const pg8::Unit& u, int wr, int wc, int fr, int fq) const {
    const int seq = seq_of_tok(u.pm * 256);
    const float* gate = ADA + (layer * 6 + seq) * 3072 + 2048;
    const int col0 = u.pn * 256 + wc * 32 + 8 * fq;
    f32x4 gv[2][2];
#pragma unroll
    for (int bj = 0; bj < 2; ++bj)
#pragma unroll
      for (int n = 0; n < 2; ++n) gv[bj][n] = *(const f32x4*)(gate + col0 + bj * 128 + 4 * n);
    const int row0 = u.pm * 256 + wr * 64 + fr;
    if (layer == 0) {
      const float* xbase = (row0 < 16384 ? xp : xs - (size_t)16384 * 1024);
      f32x4 xv[2][2], xn[2][2];
#pragma unroll
      for (int bj = 0; bj < 2; ++bj)
#pragma unroll
        for (int n = 0; n < 2; ++n) xv[bj][n] = *(const f32x4*)(xbase + (size_t)row0 * 1024 + col0 + bj * 128 + 4 * n);
#pragma unroll
      for (int k = 0; k < 8; ++k) {
        const int ai = k >> 2, m = k & 3;
        const int row = row0 + ai * 128 + m * 16;
        if (k < 7) {
          const int rn = row0 + ((k + 1) >> 2) * 128 + ((k + 1) & 3) * 16;
#pragma unroll
          for (int bj = 0; bj < 2; ++bj)
#pragma unroll
            for (int n = 0; n < 2; ++n) xn[bj][n] = *(const f32x4*)(xbase + (size_t)rn * 1024 + col0 + bj * 128 + 4 * n);
        }
#pragma unroll
        for (int bj = 0; bj < 2; ++bj)
          *(half8*)(x16out + (size_t)row * 1024 + col0 + bj * 128) = pack8(xv[bj][0] + gv[bj][0] * acc[ai][bj][m][0], xv[bj][1] + gv[bj][1] * acc[ai][bj][m][1]);
#pragma unroll
        for (int bj = 0; bj < 2; ++bj)
#pragma unroll
          for (int n = 0; n < 2; ++n) xv[bj][n] = xn[bj][n];
        asm volatile("" ::: "memory");
      }
    } else {
      half8 xv[2], xn[2];
#pragma unroll
      for (int bj = 0; bj < 2; ++bj) xv[bj] = *(const half8*)(x16in + (size_t)row0 * 1024 + col0 + bj * 128);
#pragma unroll
      for (int k = 0; k < 8; ++k) {
        const int ai = k >> 2, m = k & 3;
        const int row = row0 + ai * 128 + m * 16;
        if (k < 7) {
          const int rn = row0 + ((k + 1) >> 2) * 128 + ((k + 1) & 3) * 16;
#pragma unroll
          for (int bj = 0; bj < 2; ++bj) xn[bj] = *(const half8*)(x16in + (size_t)rn * 1024 + col0 + bj * 128);
        }
#pragma unroll
        for (int bj = 0; bj < 2; ++bj) {
          f32x4 lo, hi;
#pragma unroll
          for (int j = 0; j < 4; ++j) { lo[j] = (float)xv[bj][j]; hi[j] = (float)xv[bj][4 + j]; }
          *(half8*)(x16out + (size_t)row * 1024 + col0 + bj * 128) = pack8(lo + gv[bj][0] * acc[ai][bj][m][0], hi + gv[bj][1] * acc[ai][bj][m][1]);
        }
#pragma unroll
        for (int bj = 0; bj < 2; ++bj) xv[bj] = xn[bj];
        asm volatile("" ::: "memory");
      }
    }
  }
};
__device__ __forceinline__ void phase_out_gemm(const Params& p, int layer, const char* A, const char* Wt, char* smem) {
  const int tid = otid();
  PlainSched S; S.A = A; S.W = Wt; S.nN = 4; S.pkind = pg8::PK_P32;
  OutEpi E; E.xp = p.x_prompt; E.xs = p.x_sample; E.x16in = (const h16*)p.out; E.x16out = (layer == 3) ? (h16*)(p.ws + OFF_R3) : (h16*)p.out;
  E.ADA = (const float*)(p.ws + OFF_ADA); E.layer = layer;
  pg8::gemm_phase((LAS unsigned char*)smem, S, E, tid);
}

struct SsmInEpi {
  h16* U; h16* Z;
  __device__ __forceinline__ void operator()(const acc_t& acc, const pg8::Unit& u, int wr, int wc, int fr, int fq) const {
    const bool isz = u.pn >= 4;
    h16* dstb = (isz ? Z : U) + (u.pn & 3) * 256 + wc * 32 + 8 * fq;
#pragma unroll
    for (int ai = 0; ai < 2; ++ai)
#pragma unroll
      for (int m = 0; m < 4; ++m) {
        const int row = u.pm * 256 + ai * 128 + wr * 64 + m * 16 + fr;
#pragma unroll
        for (int bj = 0; bj < 2; ++bj) {
          f32x4 a = acc[ai][bj][m][0], b = acc[ai][bj][m][1];
          if (isz) {
#pragma unroll
            for (int j = 0; j < 4; ++j) { a[j] = silu_f(a[j]); b[j] = silu_f(b[j]); }
          }
          *(half8*)(dstb + (size_t)row * 1024 + bj * 128) = pack8(a, b);
        }
      }
  }
};
__device__ __forceinline__ void phase_ssm_in(const Params& p, char* smem) {
  const int tid = otid();
  PlainSched S; S.A = p.ws + OFF_R0; S.W = p.ws + OFF_W + WS_IN * 2; S.nN = 8; S.pkind = pg8::PK_P32;
  SsmInEpi E; E.U = (h16*)(p.ws + OFF_R1); E.Z = (h16*)(p.ws + OFF_R2);
  pg8::gemm_phase((LAS unsigned char*)smem, S, E, tid);
}

struct GluEpi {
  const h16* G; const h16* Z; h16* Y2;
  __device__ __forceinline__ void operator()(const acc_t& acc, const pg8::Unit& u, int wr, int wc, int fr, int fq) const {
    const size_t o0 = (size_t)(u.pm * 256 + wr * 64 + fr) * 1024 + u.pn * 256 + wc * 32 + 8 * fq;
    half8 gv[2], zv[2], gn[2], zn[2];
#pragma unroll
    for (int bj = 0; bj < 2; ++bj) { gv[bj] = *(const half8*)(G + o0 + bj * 128); zv[bj] = *(const half8*)(Z + o0 + bj * 128); }
#pragma unroll
    for (int ai = 0; ai < 2; ++ai)
#pragma unroll
      for (int m = 0; m < 4; ++m) {
        const size_t orow = o0 + (size_t)(ai * 128 + m * 16) * 1024;
        if (ai * 4 + m < 7) {
          const size_t onx = o0 + (size_t)(((ai * 4 + m + 1) >> 2) * 128 + ((ai * 4 + m + 1) & 3) * 16) * 1024;
#pragma unroll
          for (int bj = 0; bj < 2; ++bj) { gn[bj] = *(const half8*)(G + onx + bj * 128); zn[bj] = *(const half8*)(Z + onx + bj * 128); }
        }
#pragma unroll
        for (int bj = 0; bj < 2; ++bj) {
          const f32x4 a = acc[ai][bj][m][0], b = acc[ai][bj][m][1];
          half8 r;
#pragma unroll
          for (int j = 0; j < 4; ++j) {
            r[j] = (h16)((float)gv[bj][j] * sigmoid_f(a[j]) * (float)zv[bj][j]);
            r[4 + j] = (h16)((float)gv[bj][4 + j] * sigmoid_f(b[j]) * (float)zv[bj][4 + j]);
          }
          *(half8*)(Y2 + orow + bj * 128) = r;
        }
#pragma unroll
        for (int bj = 0; bj < 2; ++bj) { gv[bj] = gn[bj]; zv[bj] = zn[bj]; }
        asm volatile("" ::: "memory");
      }
  }
};
__device__ __forceinline__ void phase_ssm_glu(const Params& p, char* smem) {
  const int tid = otid();
  PlainSched S; S.A = p.ws + OFF_R0; S.W = p.ws + OFF_W + WS_GLU * 2; S.nN = 4; S.pkind = pg8::PK_P32;
  GluEpi E; E.G = (const h16*)(p.ws + OFF_R0); E.Z = (const h16*)(p.ws + OFF_R2); E.Y2 = (h16*)(p.ws + OFF_R1);
  pg8::gemm_phase((LAS unsigned char*)smem, S, E, tid);
}

__device__ __forceinline__ void sub_barrier(volatile LAS unsigned* cnt, unsigned& target, int lane) {
  asm volatile("s_waitcnt vmcnt(0) lgkmcnt(0)" ::: "memory");
  if (lane == 0) {
    __hip_atomic_fetch_add((LAS unsigned*)cnt, 1u, __ATOMIC_RELAXED, __HIP_MEMORY_SCOPE_WORKGROUP);
    while (__hip_atomic_load((LAS unsigned*)cnt, __ATOMIC_RELAXED, __HIP_MEMORY_SCOPE_WORKGROUP) < target) __builtin_amdgcn_s_sleep(1);
  }
  target += 4u;
  asm volatile("" ::: "memory");
}
__device__ __forceinline__ void phase_attn(const Params& p, int chunk, char* smem) {
  const int tid0 = otid(), lane = tid0 & 63, wave8 = tid0 >> 6;
  const int sub = wave8 >> 2, wave = wave8 & 3, tid = tid0 & 255;
  const h16* QK = (const h16*)(p.ws + OFF_QK);
  const h16* VT = (const h16*)(p.ws + OFF_VT);
  h16* O3 = (h16*)(p.ws + OFF_O3);
  float* LSE = (float*)(p.ws + OFF_LSE);
  const int S = chunk < 2 ? 8192 : 4096;
  constexpr int KROW = 72, VROW = 264;
  h16* Ks = (h16*)(smem + sub * ATT_LDS);
  h16* Vs = (h16*)(smem + sub * ATT_LDS + 256 * KROW * 2);
  volatile LAS unsigned* cnt = (volatile LAS unsigned*)(smem + 2 * ATT_LDS) + sub * 32;
  if (tid0 < 64) ((volatile LAS unsigned*)(smem + 2 * ATT_LDS))[tid0] = 0u;
  __syncthreads();
  unsigned target = 4u;
  const int n = lane & 31, hh = lane >> 5;
  const int qw = wave * 32;
  const int NIT = 3 * 64 * 8;
  auto decode = [&](int it0, int& hd, int& g, int& d, int& m, int& sl, int& r, int& i0) {
    const int it = it0 * 2 + sub;
    hd = it & 15; const int rest = it >> 4;
    g = rest / 64; const int blk = rest % 64;
    d = g == 0 ? 1 : (g == 1 ? 4 : 16);
    m = S / d;
    const int tp0 = blk * 128;
    sl = tp0 / S; const int w = tp0 % S; r = w / m; i0 = w % m;
  };
  half8 kreg[8], vreg[8], qpre[4];
  auto load_kq = [&](int it0) {
    int hd, g, d, m, sl, r, i0; decode(it0, hd, g, d, m, sl, r, i0);
#pragma unroll
    for (int itx = 0; itx < 8; ++itx) {
      const int idx = tid + 256 * itx;
      const int row = idx >> 3, ch = idx & 7;
      const int kj = i0 - 64 + row;
      half8 v = zero8();
      if (kj >= 0 && kj < m) v = *(const half8*)(QK + (size_t)(sl * S + kj * d + r) * 6144 + (g * 2 + 1) * 1024 + hd * 64 + ch * 8);
      kreg[itx] = v;
    }
  };
  auto load_v = [&](int it0) {
    int hd, g, d, m, sl, r, i0; decode(it0, hd, g, d, m, sl, r, i0);
    const h16* qp = QK + (size_t)(sl * S + (i0 + qw + n) * d + r) * 6144 + (g * 2) * 1024 + hd * 64 + hh * 8;
#pragma unroll
    for (int ks = 0; ks < 4; ++ks) qpre[ks] = *(const half8*)(qp + ks * 16);
#pragma unroll
    for (int itx = 0; itx < 8; ++itx) {
      const int idx = tid + 256 * itx;
      const int row = idx >> 5, ch = idx & 31;
      const int kj = i0 - 64 + ch * 8;
      half8 v = zero8();
      if (kj >= 0 && kj < m) v = *(const half8*)(VT + ((size_t)g * 1024 + hd * 64 + row) * 8192 + sl * S + r * m + kj);
      vreg[itx] = v;
    }
  };
  int it0 = obid();
  if (it0 < NIT) { load_kq(it0); load_v(it0); }
  for (; it0 < NIT; it0 += ogdim()) {
    int hd, g, d, m, sl, r, i0; decode(it0, hd, g, d, m, sl, r, i0);
    const int itn = it0 + ogdim();
#pragma unroll
    for (int itx = 0; itx < 8; ++itx) { const int idx = tid + 256 * itx; *(half8*)(Ks + (idx >> 3) * KROW + (idx & 7) * 8) = kreg[itx]; }
#pragma unroll
    for (int itx = 0; itx < 8; ++itx) { const int idx = tid + 256 * itx; *(half8*)(Vs + (idx >> 5) * VROW + (idx & 31) * 8) = vreg[itx]; }
    sub_barrier(cnt, target, lane);
    if (itn < NIT) load_kq(itn);
    f32x16 sc[5];
#pragma unroll
    for (int kb = 0; kb < 5; ++kb) {
#pragma unroll
      for (int i = 0; i < 16; ++i) sc[kb][i] = 0.f;
#pragma unroll
      for (int ks = 0; ks < 4; ++ks) {
        half8 kf = *(const half8*)(Ks + (qw + kb * 32 + n) * KROW + ks * 16 + hh * 8);
        sc[kb] = MFMA32(kf, qpre[ks], sc[kb]);
      }
      __builtin_amdgcn_sched_barrier(0);
    }
    if (itn < NIT) load_v(itn);
    const int qi = i0 + qw + n;
    const bool edge = (i0 + qw < 64) || (i0 + qw + 96 > m);
    if (edge) {
      const int lo = max(qi - 64, 0), hi = min(qi + 64, m - 1);
#pragma unroll
      for (int kb = 0; kb < 5; ++kb)
#pragma unroll
        for (int i = 0; i < 16; ++i) {
          int kj = i0 + qw - 64 + kb * 32 + 8 * (i >> 2) + 4 * hh + (i & 3);
          sc[kb][i] = (kj >= lo && kj <= hi) ? sc[kb][i] : -1e30f;
        }
    } else {
      const int nn0 = n - 4 * hh;
#pragma unroll
      for (int i = 0; i < 16; ++i) {
        const int ci = 8 * (i >> 2) + (i & 3);
        sc[0][i] = (ci >= nn0) ? sc[0][i] : -1e30f;
        sc[4][i] = (ci <= nn0) ? sc[4][i] : -1e30f;
      }
    }
    float mx = -1e30f;
#pragma unroll
    for (int kb = 0; kb < 5; ++kb)
#pragma unroll
      for (int i = 0; i < 16; ++i) mx = fmaxf(mx, sc[kb][i]);
    mx = fmaxf(mx, shx(mx, 32, lane));
    float sum = 0.f;
    half8 pfa[5][2];
#pragma unroll
    for (int kb = 0; kb < 5; ++kb)
#pragma unroll
      for (int i = 0; i < 16; ++i) {
        float pv = __builtin_amdgcn_exp2f(sc[kb][i] - mx);
        pfa[kb][i >> 3][i & 7] = (h16)pv;
        sum += pv;
      }
    sum += shx(sum, 32, lane);
    asm volatile("" : "+v"(pfa[0][0]), "+v"(pfa[0][1]), "+v"(pfa[1][0]), "+v"(pfa[1][1]), "+v"(pfa[2][0]), "+v"(pfa[2][1]), "+v"(pfa[3][0]), "+v"(pfa[3][1]), "+v"(pfa[4][0]), "+v"(pfa[4][1]));
    f32x16 oacc[2];
#pragma unroll
    for (int mb = 0; mb < 2; ++mb)
#pragma unroll
      for (int i = 0; i < 16; ++i) oacc[mb][i] = 0.f;
#pragma unroll
    for (int kb = 0; kb < 5; ++kb)
#pragma unroll
      for (int s2 = 0; s2 < 2; ++s2) {
        const half8 pf = pfa[kb][s2];
#pragma unroll
        for (int mb = 0; mb < 2; ++mb) {
          const h16* vp = Vs + (mb * 32 + n) * VROW + qw + kb * 32 + 16 * s2 + 4 * hh;
          half4 v0 = *(const half4*)(vp), v1 = *(const half4*)(vp + 8);
          half8 vf = {v0[0], v0[1], v0[2], v0[3], v1[0], v1[1], v1[2], v1[3]};
          oacc[mb] = MFMA32(vf, pf, oacc[mb]);
        }
        __builtin_amdgcn_sched_barrier(0);
      }
    float inv = 1.f / sum;
    int tl = sl * S + qi * d + r;
    h16* op = O3 + ((size_t)g * 8192 + tl) * 1024 + hd * 64;
#pragma unroll
    for (int mb = 0; mb < 2; ++mb)
#pragma unroll
      for (int pq = 0; pq < 2; ++pq) {
        union { half4 h; int w[2]; } he, ho, rv;
#pragma unroll
        for (int rr = 0; rr < 4; ++rr) { he.h[rr] = (h16)(oacc[mb][8 * pq + rr] * inv); ho.h[rr] = (h16)(oacc[mb][8 * pq + 4 + rr] * inv); }
        const int s0 = hh ? he.w[0] : ho.w[0], s1 = hh ? he.w[1] : ho.w[1];
        rv.w[0] = __builtin_amdgcn_ds_bpermute((lane ^ 32) << 2, s0);
        rv.w[1] = __builtin_amdgcn_ds_bpermute((lane ^ 32) << 2, s1);
        const half4 lo = hh ? rv.h : he.h, hi = hh ? ho.h : rv.h;
        const half8 o = {lo[0], lo[1], lo[2], lo[3], hi[0], hi[1], hi[2], hi[3]};
        *(half8*)(op + mb * 32 + 8 * (2 * pq + hh)) = o;
      }
    if (hh == 0) LSE[((size_t)g * 8192 + tl) * 16 + hd] = (mx + __builtin_amdgcn_logf(sum)) * 0.6931471805599453f;
    sub_barrier(cnt, target, lane);
  }
  __syncthreads();
}

__device__ __forceinline__ void phase_attn_combine(const Params& p, int chunk) {
  const h16* O3 = (const h16*)(p.ws + OFF_O3);
  const float* LSE = (const float*)(p.ws + OFF_LSE);
  const h16* ZC = (const h16*)(p.ws + OFF_ZC);
  h16* YA = (h16*)(p.ws + OFF_R0) + (size_t)chunk * 8192 * 1024;
  for (int it = obid(); it < 8192 * 128 / NT; it += ogdim()) {
    int idx = it * NT + otid();
    int tl = idx >> 7, c8 = idx & 127;
    int hd = c8 >> 3;
    float l0 = LSE[((size_t)0 * 8192 + tl) * 16 + hd], l1 = LSE[((size_t)1 * 8192 + tl) * 16 + hd], l2 = LSE[((size_t)2 * 8192 + tl) * 16 + hd];
    float mx = fmaxf(l0, fmaxf(l1, l2));
    float w0 = __expf(l0 - mx), w1 = __expf(l1 - mx), w2 = __expf(l2 - mx);
    float inv = __builtin_amdgcn_rcpf(w0 + w1 + w2);
    w0 *= inv; w1 *= inv; w2 *= inv;
    size_t off = (size_t)tl * 1024 + c8 * 8;
    half8 a = *(const half8*)(O3 + off), b = *(const half8*)(O3 + (size_t)8192 * 1024 + off), c = *(const half8*)(O3 + (size_t)2 * 8192 * 1024 + off);
    half8 z = *(const half8*)(ZC + off);
    half8 o;
#pragma unroll
    for (int j = 0; j < 8; ++j) o[j] = (h16)((w0 * (float)a[j] + w1 * (float)b[j] + w2 * (float)c[j]) * (float)z[j]);
    *(half8*)(YA + off) = o;
  }
}

struct ScanPar { float lbr[2], lbi[2], nlbi[2], dt; half8 Bop[4]; half8 Cop[4]; };
__device__ __forceinline__ void scan_setup(const Params& p, int j, int dir, int g, int lane, bool needC, ScanPar& P) {
  const int n = lane & 31, hh = lane >> 5;
  const size_t pbase = (((size_t)j * 2 + dir) * 64 + g);
  const float dt = __expf(p.log_dt[pbase]);
  P.dt = dt;
  float fr[2], fi[2];
#pragma unroll
  for (int s = 0; s < 2; ++s) {
    int st = n + 32 * s;
    float lre = fminf(p.lam_re[pbase * 64 + st], -1e-4f);
    float lim = p.lam_im[pbase * 64 + st];
    float zr = lre * dt, zi = lim * dt;
    float er = __expf(zr);
    float sn, cs, snh, csh;
    sincos_acc(zi, sn, cs);
    sincos_acc(0.5f * zi, snh, csh);
    P.lbr[s] = er * cs;
    P.lbi[s] = er * sn;
    P.nlbi[s] = -P.lbi[s];
    float nr = expm1f(zr) * cs - 2.f * snh * snh, ni = er * sn;
    float den = 1.f / (zr * zr + zi * zi);
    fr[s] = (nr * zr + ni * zi) * den;
    fi[s] = (ni * zr - nr * zi) * den;
  }
#pragma unroll
  for (int s = 0; s < 2; ++s) {
    int st = n + 32 * s;
    const float* br = p.b_re + (pbase * 64 + st) * 16 + 8 * hh;
    const float* bi = p.b_im + (pbase * 64 + st) * 16 + 8 * hh;
#pragma unroll
    for (int jj = 0; jj < 8; ++jj) {
      float a = br[jj], b = bi[jj];
      P.Bop[2 * s][jj] = (h16)(fr[s] * a - fi[s] * b);
      P.Bop[2 * s + 1][jj] = (h16)(fr[s] * b + fi[s] * a);
    }
  }
  if (needC) {
    int ch = lane & 15, qd = lane >> 4;
#pragma unroll
    for (int kb = 0; kb < 4; ++kb)
#pragma unroll
      for (int jj = 0; jj < 8; ++jj) {
        int kap = 32 * kb + 8 * qd + jj;
        int np = kap >> 2, which = kap & 3;
        int st = np + 32 * (which >> 1);
        size_t ci = (pbase * 16 + ch) * 64 + st;
        P.Cop[kb][jj] = (which & 1) ? (h16)(-p.c_im[ci]) : (h16)(p.c_re[ci]);
      }
  }
}
template <int MODE>
__device__ __forceinline__ void scan_run(const Params& p, const ScanPar& P, const int dir, const int g, const int sp, const int lane, h16* X, const f32x4 dsk) {
  const int n = lane & 31, hh = lane >> 5;
  const h16* U = (const h16*)(p.ws + OFF_R1);
  h16* Y = (h16*)(p.ws + OFF_R0);
  float4* ENDS = (float4*)(p.ws + OFF_ENDS);
  constexpr int XROW = 136;
  const int pairtok = sp * 512;
  const int S = pairtok < 16384 ? 8192 : 4096;
  const int seqstart = pairtok < 16384 ? (pairtok & ~8191) : 16384 + ((pairtok - 16384) & ~4095);
  const int segt = ((pairtok - seqstart) >> 8) + hh;
  const int nseg = S >> 8;
  const int segstart = seqstart + segt * 256;
  const int gseg0 = seqstart >> 8;
  float xr0 = 0.f, xi0 = 0.f, xr1 = 0.f, xi1 = 0.f;
  if (MODE != 0) {
    float pr0 = P.lbr[0], pi0 = P.lbi[0], pr1 = P.lbr[1], pi1 = P.lbi[1];
#pragma unroll
    for (int q = 0; q < 8; ++q) {
      float a = pr0 * pr0 - pi0 * pi0, b = 2.f * pr0 * pi0; pr0 = a; pi0 = b;
      float c = pr1 * pr1 - pi1 * pi1, dd = 2.f * pr1 * pi1; pr1 = c; pi1 = dd;
    }
    const float4* eb = ENDS + ((size_t)(dir * 64 + g) * 128) * 32;
    int cnt = dir == 0 ? segt : (nseg - 1 - segt);
    for (int c = 0; c < cnt; ++c) {
      int sg = dir == 0 ? c : (nseg - 1 - c);
      float4 e = eb[(size_t)(gseg0 + sg) * 32 + n];
      float a = pr0 * xr0 - pi0 * xi0 + e.x, b = pr0 * xi0 + pi0 * xr0 + e.y;
      xr0 = a; xi0 = b;
      float c2 = pr1 * xr1 - pi1 * xi1 + e.z, d2 = pr1 * xi1 + pi1 * xr1 + e.w;
      xr1 = c2; xi1 = d2;
    }
  }
  const int am = lane & 31;
  const int ahalf = (am >> 2) & 1, astep = ((am >> 3) << 2) | (am & 3);
  const int asegstart = seqstart + (((pairtok - seqstart) >> 8) + ahalf) * 256;
  const h16* ubase = U + g * 16 + 8 * (lane >> 5);
  auto utok = [&](int ci) { int tau = ci * 16 + astep; return dir ? (asegstart + 255 - tau) : (asegstart + tau); };
  half8 unext = *(const half8*)(ubase + (size_t)utok(0) * 1024);
  for (int ci = 0; ci < 16; ++ci) {
    half8 ua = unext;
    if (ci + 1 < 16) unext = *(const half8*)(ubase + (size_t)utok(ci + 1) * 1024);
    const int trow = lane & 15, qd = lane >> 4;
    half4 uo[2]; unsigned yp[2][2];
    if (MODE == 2) {
#pragma unroll
      for (int h2 = 0; h2 < 2; ++h2) {
        int sst = seqstart + (((pairtok - seqstart) >> 8) + h2) * 256;
        int tau = ci * 16 + trow;
        int tok = dir ? (sst + 255 - tau) : (sst + tau);
        const size_t off = (size_t)tok * 1024 + g * 16 + 4 * qd;
        uo[h2] = *(const half4*)(U + off);
        yp[h2][0] = __hip_atomic_load((unsigned*)(Y + off), __ATOMIC_RELAXED, __HIP_MEMORY_SCOPE_AGENT);
        yp[h2][1] = __hip_atomic_load((unsigned*)(Y + off) + 1, __ATOMIC_RELAXED, __HIP_MEMORY_SCOPE_AGENT);
      }
    }
    f32x16 bu[4];
#pragma unroll
    for (int nb = 0; nb < 4; ++nb) {
      f32x16 z;
#pragma unroll
      for (int i = 0; i < 16; ++i) z[i] = 0.f;
      bu[nb] = MFMA32(ua, P.Bop[nb], z);
    }
#pragma unroll
    for (int i = 0; i < 16; ++i) {
      float a = afma(P.lbr[0], xr0, afma(P.nlbi[0], xi0, bu[0][i]));
      float b = afma(P.lbr[0], xi0, afma(P.lbi[0], xr0, bu[1][i]));
      xr0 = a; xi0 = b;
      float c = afma(P.lbr[1], xr1, afma(P.nlbi[1], xi1, bu[2][i]));
      float dd = afma(P.lbr[1], xi1, afma(P.lbi[1], xr1, bu[3][i]));
      xr1 = c; xi1 = dd;
      asm volatile("" : "+v"(xr0), "+v"(xi0), "+v"(xr1), "+v"(xi1));
      if (MODE != 0) {
        half4 hv = {(h16)xr0, (h16)xi0, (h16)xr1, (h16)xi1};
        *(half4*)(X + (hh * 16 + i) * XROW + 4 * n) = hv;
      }
    }
    if (MODE != 0) {
      asm volatile("s_waitcnt lgkmcnt(0)" ::: "memory");
#pragma unroll
      for (int h2 = 0; h2 < 2; ++h2) {
        f32x4 y = {0.f, 0.f, 0.f, 0.f};
#pragma unroll
        for (int kb = 0; kb < 4; ++kb) {
          half8 xb = *(const half8*)(X + (h2 * 16 + trow) * XROW + 32 * kb + 8 * qd);
          y = MFMA16(P.Cop[kb], xb, y);
        }
        int sst = seqstart + (((pairtok - seqstart) >> 8) + h2) * 256;
        int tau = ci * 16 + trow;
        int tok = dir ? (sst + 255 - tau) : (sst + tau);
        h16* dst = Y + (size_t)tok * 1024 + g * 16 + 4 * qd;
        if (MODE == 1) {
          half4 o = {(h16)(y[0] * P.dt), (h16)(y[1] * P.dt), (h16)(y[2] * P.dt), (h16)(y[3] * P.dt)};
          *(half4*)dst = o;
        } else {
          union { unsigned w[2]; half4 h; } cv; cv.w[0] = yp[h2][0]; cv.w[1] = yp[h2][1];
          half4 o;
#pragma unroll
          for (int k = 0; k < 4; ++k) o[k] = (h16)gelu_tanh(dsk[k] * (float)uo[h2][k] + (float)cv.h[k] + y[k] * P.dt);
          *(half4*)dst = o;
        }
      }
      asm volatile("s_waitcnt lgkmcnt(0)" ::: "memory");
    }
  }
  if (MODE == 0) ENDS[((size_t)(dir * 64 + g) * 128 + (segstart >> 8)) * 32 + n] = make_float4(xr0, xi0, xr1, xi1);
}
__device__ __forceinline__ void phase_scan1(const Params& p, int j, char* smem) {
  const int tid = otid(), lane = tid & 63, wave = tid >> 6;
  const int nwaves = ogdim() * 8;
  const int wpc = nwaves >> 7;
  const int wglob = obid() * 8 + wave;
  if (wglob < wpc * 128) {
    const int combo = wglob & 127, slot = wglob >> 7;
    const int dir = combo & 1, g = combo >> 1;
    ScanPar P; scan_setup(p, j, dir, g, lane, false, P);
    const f32x4 dz = {0.f, 0.f, 0.f, 0.f};
    for (int sp = slot; sp < 64; sp += wpc) scan_run<0>(p, P, dir, g, sp, lane, (h16*)smem, dz);
  }
}
__device__ __forceinline__ void phase_scan2(const Params& p, int j, char* smem) {
  const int tid = otid(), lane = tid & 63, wave = tid >> 6;
  h16* X = (h16*)smem + wave * 32 * 136;
  const int nwaves = ogdim() * 8;
  const int wpg = nwaves >> 6;
  const int wglob = obid() * 8 + wave;
  if (wglob < wpg * 64) {
    const int g = wglob & 63, slot = wglob >> 6;
    ScanPar P0, P1;
    scan_setup(p, j, 0, g, lane, true, P0);
    scan_setup(p, j, 1, g, lane, true, P1);
    const f32x4 dsk = *(const f32x4*)(p.ssm_d + j * 1024 + g * 16 + 4 * (lane >> 4));
    for (int sp = slot; sp < 64; sp += wpg) {
      scan_run<1>(p, P0, 0, g, sp, lane, X, dsk);
      asm volatile("s_waitcnt vmcnt(0)" ::: "memory");
      scan_run<2>(p, P1, 1, g, sp, lane, X, dsk);
    }
  }
}

#define XB_TMO      128
#define XB_XCNT(j)  (256  + 64 * (j))
#define XB_XSUB(j)  (1280 + 64 * (j))
#define XB_XGEN(j)  (2304 + 64 * (j))
#define XB_TOP      3328
#define XB_TOPGEN   3392
#define XCD_BAR_WORDS 3456
#define XB_SPIN_CAP (1u << 22)
__device__ __forceinline__ unsigned xb_ld(unsigned* p)              { return __hip_atomic_load(p, __ATOMIC_RELAXED, __HIP_MEMORY_SCOPE_AGENT); }
__device__ __forceinline__ unsigned xb_add(unsigned* p, unsigned v) { return __hip_atomic_fetch_add(p, v, __ATOMIC_RELAXED, __HIP_MEMORY_SCOPE_AGENT); }
__device__ __forceinline__ unsigned xb_xcc_id() { return (unsigned)__builtin_amdgcn_s_getreg((3 << 11) | 20) & 0xFu; }
#define XB_SPIN(cond, bar) do { unsigned _sp = 0; while (cond) { __builtin_amdgcn_s_sleep(1); \
    if ((++_sp & 255u) == 0u) { if (xb_ld(&(bar)[XB_TMO])) break; if (_sp > XB_SPIN_CAP) { atomicAdd(&(bar)[XB_TMO], 1u); break; } } } } while (0)
struct XcdBarrier { unsigned* bar; unsigned x; volatile LAS unsigned* st; };
__device__ __forceinline__ XcdBarrier xcd_barrier_post(unsigned* bar, volatile LAS unsigned* st) {
  XcdBarrier b; b.bar = bar; b.x = xb_xcc_id(); b.st = st;
  if (threadIdx.x == 0) (void)xb_add(&bar[XB_XCNT(b.x)], 1u);
  return b;
}
__device__ __forceinline__ void xcd_barrier_complete(unsigned* bar, unsigned x, unsigned& nloc, unsigned& nx) {
  const unsigned G = gridDim.x * gridDim.y * gridDim.z;
  unsigned sum, cnt, mine, sp = 0u;
  for (;;) {
    sum = 0u; cnt = 0u; mine = 0u;
#pragma unroll
    for (unsigned j = 0; j < 16; ++j) { const unsigned c = xb_ld(&bar[XB_XCNT(j)]); sum += c; cnt += (c > 0u) ? 1u : 0u; mine = (j == x) ? c : mine; }
    if (sum == G) break;
    __builtin_amdgcn_s_sleep(1);
    if ((++sp & 255u) == 0u) { if (xb_ld(&bar[XB_TMO])) break; if (sp > XB_SPIN_CAP) { atomicAdd(&bar[XB_TMO], 1u); break; } }
  }
  nloc = mine > 0u ? mine : 1u; nx = cnt > 0u ? cnt : 1u;
}
__device__ __forceinline__ void xcd_barrier(const XcdBarrier& b) {
  asm volatile("s_waitcnt vmcnt(0)" ::: "memory");
  __syncthreads();
  if (threadIdx.x == 0) {
    unsigned* bar = b.bar;
    __builtin_amdgcn_s_waitcnt(0);
    unsigned nloc = b.st[0], nx = b.st[1];
    if (nloc == 0u) { xcd_barrier_complete(bar, b.x, nloc, nx); b.st[0] = nloc; b.st[1] = nx; }
    const unsigned old = xb_add(&bar[XB_XSUB(b.x)], 1u);
    const unsigned gen = old / nloc;
    if (old + 1u == (gen + 1u) * nloc) {
      __builtin_amdgcn_fence(__ATOMIC_RELEASE, "agent");
      asm volatile("s_waitcnt vmcnt(0)" ::: "memory");
      const unsigned og = xb_add(&bar[XB_TOP], 1u);
      const unsigned tg = og / nx;
      if (og + 1u == (tg + 1u) * nx) xb_add(&bar[XB_TOPGEN], 1u);
      else XB_SPIN(xb_ld(&bar[XB_TOPGEN]) == tg, bar);
      __builtin_amdgcn_fence(__ATOMIC_ACQUIRE, "agent");
      xb_add(&bar[XB_XGEN(b.x)], 1u);
      asm volatile("s_waitcnt vmcnt(0)" ::: "memory");
    } else {
      XB_SPIN(xb_ld(&bar[XB_XGEN(b.x)]) == gen, bar);
      __builtin_amdgcn_fence(__ATOMIC_ACQUIRE, "agent");
      asm volatile("s_waitcnt vmcnt(0)" ::: "memory");
    }
  }
  __syncthreads();
}

#ifndef PROBE_DUP
#define PROBE_DUP 0
#endif
#define SYNC() do { XcdBarrier xb_; xb_.bar = (unsigned*)(p.ws + OFF_BAR); xb_.x = xb_xcc_id(); xb_.st = (volatile LAS unsigned*)(smem + 147456); xcd_barrier(xb_); } while (0)
__global__ void __launch_bounds__(NT, 2) mega(Params p) {
  extern __shared__ __attribute__((aligned(16))) char smem[];
  if (p.ws == nullptr) cg::this_grid().sync();
  if (threadIdx.x == 0) *(uint4*)(smem + 147456) = make_uint4(0u, 0u, 0u, 0u);
  __syncthreads();
  (void)xcd_barrier_post((unsigned*)(p.ws + OFF_BAR), (volatile LAS unsigned*)(smem + 147456));
  phase0(p, smem);
  SYNC();
  for (int layer = 0; layer < 4; ++layer) {
    phase_norm(p, layer, smem);
    SYNC();
    if (PROBE_DUP & 32) { phase_norm(p, layer, smem); SYNC(); }
    if ((layer & 1) == 0) {
      for (int chunk = 0; chunk < 4; ++chunk) {
        phase_attn_in(p, chunk, smem);
        SYNC();
        if (PROBE_DUP & 16) { phase_attn_in(p, chunk, smem); SYNC(); }
        phase_attn(p, chunk, smem);
        SYNC();
        if (PROBE_DUP & 1) { phase_attn(p, chunk, smem); SYNC(); }
        phase_attn_combine(p, chunk);
        SYNC();
        if (PROBE_DUP & 64) { phase_attn_combine(p, chunk); SYNC(); }
      }
      phase_out_gemm(p, layer, p.ws + OFF_R0, p.ws + OFF_W + WA_OUT * 2, smem);
      SYNC();
    } else {
      int j = layer >> 1;
      phase_ssm_in(p, smem);
      SYNC();
      phase_scan1(p, j, smem);
      SYNC();
      phase_scan2(p, j, smem);
      SYNC();
      phase_ssm_glu(p, smem);
      SYNC();
      if (PROBE_DUP & 128) { phase_ssm_glu(p, smem); SYNC(); }
      phase_out_gemm(p, layer, p.ws + OFF_R1, p.ws + OFF_W + WS_OUT * 2, smem);
      SYNC();
    }
  }
  phase_final_norm(p);
}

extern "C" void kernel_launch(void* const* d_in, const int* in_sizes, int n_in, void* d_out, int out_size,
                              void* d_ws, size_t ws_size, hipStream_t stream) {
  static int grid_blocks = 0;
  if (!grid_blocks) {
    int dev = 0, cus = 0, per_cu = 0;
    hipGetDevice(&dev);
    hipDeviceGetAttribute(&cus, hipDeviceAttributeMultiprocessorCount, dev);
    hipFuncSetAttribute((const void*)mega, hipFuncAttributeMaxDynamicSharedMemorySize, SMEM_BYTES);
    hipOccupancyMaxActiveBlocksPerMultiprocessor(&per_cu, mega, NT, SMEM_BYTES);
    (void)hipGetLastError();
    grid_blocks = cus;
  }
  Params p{};
  p.x_prompt = (const float*)d_in[0]; p.x_sample = (const float*)d_in[1];
  p.c_prompt = (const float*)d_in[2]; p.c_sample = (const float*)d_in[3];
  p.norm_g = (const float*)d_in[4]; p.ada_w = (const float*)d_in[5]; p.ada_b = (const float*)d_in[6];
  p.attn_w_in = (const float*)d_in[7]; p.attn_w_out = (const float*)d_in[8]; p.ssm_w_in = (const float*)d_in[9];
  p.lam_re = (const float*)d_in[10]; p.lam_im = (const float*)d_in[11]; p.log_dt = (const float*)d_in[12];
  p.b_re = (const float*)d_in[13]; p.b_im = (const float*)d_in[14]; p.c_re = (const float*)d_in[15]; p.c_im = (const float*)d_in[16];
  p.ssm_d = (const float*)d_in[17]; p.w_glu = (const float*)d_in[18]; p.w_out = (const float*)d_in[19]; p.final_g = (const float*)d_in[20];
  p.out = (float*)d_out;
  p.ws = (char*)d_ws;
  hipMemsetAsync((char*)d_ws + OFF_BAR, 0, XCD_BAR_WORDS * sizeof(unsigned), stream);
  void* args[] = {&p};
  hipError_t e = hipLaunchCooperativeKernel((void*)mega, dim3(grid_blocks), dim3(NT), args, SMEM_BYTES, stream);
  if (e != hipSuccess) fprintf(stderr, "coop launch failed: %s (grid %d)\n", hipGetErrorString(e), grid_blocks);
}
```

```cpp
#include <hip/hip_runtime.h>
#include <hip/hip_cooperative_groups.h>
#include <cstdio>
#include <cstdint>
namespace cg = cooperative_groups;

typedef _Float16 h16;
typedef _Float16 half8 __attribute__((ext_vector_type(8)));
typedef _Float16 half4 __attribute__((ext_vector_type(4)));
typedef float f32x16 __attribute__((ext_vector_type(16)));
typedef float f32x4 __attribute__((ext_vector_type(4)));

#define NT 512
#define LAS __attribute__((address_space(3)))
#define MFMA32(a, b, c) __builtin_amdgcn_mfma_f32_32x32x16_f16(a, b, c, 0, 0, 0)
#define MFMA16(a, b, c) __builtin_amdgcn_mfma_f32_16x16x32_f16(a, b, c, 0, 0, 0)

constexpr int D = 1024;
constexpr int NTOK = 32768;
constexpr size_t MiB = 1024 * 1024;
constexpr size_t OFF_W = 0;
constexpr size_t OFF_ROPE = 24 * MiB;
constexpr size_t OFF_ADA = 26 * MiB;
constexpr size_t OFF_LSE = 27 * MiB;
constexpr size_t OFF_ENDS = 30 * MiB;
constexpr size_t OFF_BAR = 38 * MiB;
constexpr size_t OFF_R0 = 40 * MiB;
constexpr size_t OFF_BIG = 104 * MiB;
constexpr size_t OFF_QK = OFF_BIG;
constexpr size_t OFF_VT = OFF_BIG + 96 * MiB;
constexpr size_t OFF_ZC = OFF_BIG + 144 * MiB;
constexpr size_t OFF_O3 = OFF_BIG + 160 * MiB;
constexpr size_t OFF_R1 = OFF_BIG;
constexpr size_t OFF_R2 = OFF_BIG + 64 * MiB;
constexpr size_t OFF_R3 = OFF_BIG + 128 * MiB;
constexpr size_t WA_IN = 0;
constexpr size_t WA_OUT = (size_t)10240 * 1024;
constexpr size_t WS_IN = 0;
constexpr size_t WS_GLU = (size_t)2048 * 1024;
constexpr size_t WS_OUT = (size_t)3072 * 1024;

constexpr int ATT_LDS = 70656;
constexpr int SMEM_BYTES = 147456 + 16;

struct Params {
  const float *x_prompt, *x_sample, *c_prompt, *c_sample, *norm_g, *ada_w, *ada_b, *attn_w_in, *attn_w_out,
      *ssm_w_in, *lam_re, *lam_im, *log_dt, *b_re, *b_im, *c_re, *c_im, *ssm_d, *w_glu, *w_out, *final_g;
  float* out;
  char* ws;
};

__device__ __forceinline__ int otid() { int t = threadIdx.x; asm volatile("" : "+v"(t)); return t; }
__device__ __forceinline__ float afma(float a, float b, float c) { return __builtin_fmaf(a, b, c); }
__device__ __forceinline__ half8 pack8(f32x4 a, f32x4 b) { half8 o = {(h16)a[0], (h16)a[1], (h16)a[2], (h16)a[3], (h16)b[0], (h16)b[1], (h16)b[2], (h16)b[3]}; return o; }
__device__ __forceinline__ int obid() { int b = blockIdx.x; asm volatile("" : "+s"(b)); return b; }
__device__ __forceinline__ int ogdim() { int b = gridDim.x; asm volatile("" : "+s"(b)); return b; }
__device__ __forceinline__ half8 zero8() { float z = 0.f; asm volatile("" : "+v"(z)); f32x4 t = {z, z, z, z}; return __builtin_bit_cast(half8, t); }
__device__ __forceinline__ float shx(float v, int mask, int lane) { return __int_as_float(__builtin_amdgcn_ds_bpermute((lane ^ mask) << 2, __float_as_int(v))); }
__device__ __forceinline__ int seq_of_tok(int t) { return t < 16384 ? (t >> 13) : 2 + ((t - 16384) >> 12); }
__device__ __forceinline__ float silu_f(float x) { return x * __builtin_amdgcn_rcpf(1.f + __expf(-x)); }
__device__ __forceinline__ float sigmoid_f(float x) { return __builtin_amdgcn_rcpf(1.f + __expf(-x)); }
__device__ __forceinline__ float gelu_tanh(float x) {
  float u = 0.7978845608028654f * (x + 0.044715f * x * x * x);
  float t = 1.f - 2.f * __builtin_amdgcn_rcpf(1.f + __expf(2.f * u));
  return 0.5f * x * (1.f + t);
}

__device__ __forceinline__ void sincos_acc(float angf, float& s, float& c) {
  double a = (double)angf;
  double kd = rint(a * 0.6366197723675814);
  double r = a - kd * 1.5707963267948966 - kd * 6.123233995736766e-17;
  int k = ((int)kd) & 3;
  double r2 = r * r;
  double sp = r * (1.0 + r2 * (-1.0 / 6 + r2 * (1.0 / 120 + r2 * (-1.0 / 5040 + r2 * (1.0 / 362880 + r2 * (-1.0 / 39916800 + r2 * (1.0 / 6227020800.0)))))));
  double cp = 1.0 + r2 * (-0.5 + r2 * (1.0 / 24 + r2 * (-1.0 / 720 + r2 * (1.0 / 40320 + r2 * (-1.0 / 3628800 + r2 * (1.0 / 479001600 + r2 * (-1.0 / 87178291200.0)))))));
  double ss = (k & 1) ? cp : sp;
  double cc = (k & 1) ? sp : cp;
  if (k == 1) cc = -cc;
  if (k == 2) { ss = -ss; cc = -cc; }
  if (k == 3) ss = -ss;
  s = (float)ss;
  c = (float)cc;
}

__device__ __forceinline__ void convert_tile(const float* __restrict__ src, h16* __restrict__ dst, int N, int tile, char* smem) {
  float(*t)[129] = (float(*)[129])smem;
  const int ctid = otid();
  int ntn = N >> 7;
  int k0 = (tile / ntn) << 6, n0 = (tile % ntn) << 7;
  int tx = ctid & 31, ty = ctid >> 5;
#pragma unroll
  for (int i = 0; i < 4; ++i) {
    int k = ty + 16 * i;
    float4 v = *(const float4*)(src + (size_t)(k0 + k) * N + n0 + 4 * tx);
    t[k][4 * tx + 0] = v.x; t[k][4 * tx + 1] = v.y; t[k][4 * tx + 2] = v.z; t[k][4 * tx + 3] = v.w;
  }
  __syncthreads();
#pragma unroll
  for (int i = 0; i < 2; ++i) {
    int idx = ctid + 512 * i;
    int nn = idx >> 3, kc = idx & 7;
    half8 o;
#pragma unroll
    for (int j = 0; j < 8; ++j) o[j] = (h16)t[kc * 8 + j][nn];
    *(half8*)(dst + (size_t)(n0 + nn) * 1024 + k0 + kc * 8) = o;
  }
  __syncthreads();
}

__device__ __forceinline__ void convert_layer_weights(const Params& p, int layer, int item0, int nitems_before, char* smem) {
  h16* W = (h16*)(p.ws + OFF_W);
  int j = layer >> 1;
  if ((layer & 1) == 0) {
    const int n_in = 16 * 80, n_out = 128;
    for (int it = item0; it < nitems_before + n_in + n_out; it += ogdim()) {
      int t = it - nitems_before;
      if (t < 0) continue;
      if (t < n_in) convert_tile(p.attn_w_in + (size_t)j * 1024 * 10240, W + WA_IN, 10240, t, smem);
      else convert_tile(p.attn_w_out + (size_t)j * 1024 * 1024, W + WA_OUT, 1024, t - n_in, smem);
    }
  } else {
    const int n_in = 16 * 16, n_g = 128, n_o = 128;
    for (int it = item0; it < nitems_before + n_in + n_g + n_o; it += ogdim()) {
      int t = it - nitems_before;
      if (t < 0) continue;
      if (t < n_in) convert_tile(p.ssm_w_in + (size_t)j * 1024 * 2048, W + WS_IN, 2048, t, smem);
      else if (t < n_in + n_g) convert_tile(p.w_glu + (size_t)j * 1024 * 1024, W + WS_GLU, 1024, t - n_in, smem);
      else convert_tile(p.w_out + (size_t)j * 1024 * 1024, W + WS_OUT, 1024, t - n_in - n_g, smem);
    }
  }
}

__device__ __forceinline__ void phase0(const Params& p, char* smem) {
  const int tid = otid(); const int lane = tid & 63, wave = tid >> 6;
  const int N_ADA = 192, N_ROPE = 512;
  float* ADA = (float*)(p.ws + OFF_ADA);
  float2* ROPE = (float2*)(p.ws + OFF_ROPE);
  int it = obid();
  for (; it < N_ADA; it += ogdim()) {
    int layer = it / 48, cb = it % 48;
    float* sc = (float*)smem;
    float* red = (float*)(smem + 6 * 1024 * 4);
    for (int i = tid; i < 6144; i += NT) {
      int s = i >> 10, k = i & 1023;
      float c = s < 2 ? p.c_prompt[s * 1024 + k] : p.c_sample[(s - 2) * 1024 + k];
      sc[i] = silu_f(c);
    }
    __syncthreads();
    int col = cb * 64 + lane;
    float acc[6] = {0.f, 0.f, 0.f, 0.f, 0.f, 0.f};
    const float* wp = p.ada_w + ((size_t)layer * 1024 + wave * 128) * 3072 + col;
#pragma unroll 1
    for (int k0 = 0; k0 < 128; k0 += 32) {
      float wv[32];
#pragma unroll
      for (int k = 0; k < 32; ++k) wv[k] = wp[(size_t)(k0 + k) * 3072];
#pragma unroll
      for (int k = 0; k < 32; ++k)
#pragma unroll
        for (int s = 0; s < 6; ++s) acc[s] += sc[s * 1024 + wave * 128 + k0 + k] * wv[k];
    }
#pragma unroll
    for (int s = 0; s < 6; ++s) red[(wave * 6 + s) * 64 + lane] = acc[s];
    __syncthreads();
    if (wave == 0) {
#pragma unroll
      for (int s = 0; s < 6; ++s) {
        float v = 0.f;
#pragma unroll
        for (int w8 = 0; w8 < 8; ++w8) v += red[(w8 * 6 + s) * 64 + lane];
        ADA[(layer * 6 + s) * 3072 + col] = v + p.ada_b[layer * 3072 + col];
      }
    }
    __syncthreads();
  }
  for (; it < N_ADA + N_ROPE; it += ogdim()) {
    int idx = (it - N_ADA) * NT + tid;
    int pos = idx >> 5, e = idx & 31;
    float invf = (float)exp(-(double)(2 * e) / 64.0 * 9.210340371976184);
    float ang = (float)pos * invf;
    float s, c;
    sincos_acc(ang, s, c);
    ROPE[idx] = make_float2(c, s);
  }
  convert_layer_weights(p, 0, it, N_ADA + N_ROPE, smem);
}

__device__ __forceinline__ void phase_norm(const Params& p, int layer, char* smem) {
  const int tid = otid(); const int lane = tid & 63, wave = tid >> 6;
  h16* H = (h16*)(p.ws + OFF_R0);
  const float* ADA = (const float*)(p.ws + OFF_ADA);
  const float* g = p.norm_g + layer * 1024;
  int it = obid();
  if (layer == 0) {
    auto rowptr = [&](int row) -> const float4* { return (const float4*)(row < 16384 ? p.x_prompt + (size_t)row * 1024 : p.x_sample + (size_t)(row - 16384) * 1024); };
    float4 gg[4], sh[4], scl[4];
#pragma unroll
    for (int j = 0; j < 4; ++j) gg[j] = *(const float4*)(g + 4 * (lane + 64 * j));
    int cur_seq = -1;
    float4 vn[4];
    if (it < NTOK / 8) {
      const float4* xr = rowptr(it * 8 + wave);
#pragma unroll
      for (int j = 0; j < 4; ++j) vn[j] = xr[lane + 64 * j];
    }
    for (; it < NTOK / 8; it += ogdim()) {
      const int row = it * 8 + wave;
      float4 v[4];
#pragma unroll
      for (int j = 0; j < 4; ++j) v[j] = vn[j];
      const int itn = it + ogdim();
      if (itn < NTOK / 8) {
        const float4* xr = rowptr(itn * 8 + wave);
#pragma unroll
        for (int j = 0; j < 4; ++j) vn[j] = xr[lane + 64 * j];
      }
      const int seq = seq_of_tok(row);
      if (seq != cur_seq) {
        cur_seq = seq;
        const float* ada = ADA + (layer * 6 + seq) * 3072;
#pragma unroll
        for (int j = 0; j < 4; ++j) { sh[j] = *(const float4*)(ada + 4 * (lane + 64 * j)); scl[j] = *(const float4*)(ada + 1024 + 4 * (lane + 64 * j)); }
      }
      float ss = 0.f;
#pragma unroll
      for (int j = 0; j < 4; ++j) ss += v[j].x * v[j].x + v[j].y * v[j].y + v[j].z * v[j].z + v[j].w * v[j].w;
#pragma unroll
      for (int o = 32; o >= 1; o >>= 1) ss += shx(ss, o, lane);
      float rstd = rsqrtf(ss * (1.f / 1024.f) + 1e-6f);
#pragma unroll
      for (int j = 0; j < 4; ++j) {
        int idx = 4 * (lane + 64 * j);
        half4 o;
        o[0] = (h16)(v[j].x * rstd * gg[j].x * (1.f + scl[j].x) + sh[j].x);
        o[1] = (h16)(v[j].y * rstd * gg[j].y * (1.f + scl[j].y) + sh[j].y);
        o[2] = (h16)(v[j].z * rstd * gg[j].z * (1.f + scl[j].z) + sh[j].z);
        o[3] = (h16)(v[j].w * rstd * gg[j].w * (1.f + scl[j].w) + sh[j].w);
        *(half4*)(H + (size_t)row * 1024 + idx) = o;
      }
    }
  } else {
    const h16* X16 = (const h16*)p.out;
    f32x4 gg[2][2], sh[2][2], scl[2][2];
#pragma unroll
    for (int j = 0; j < 2; ++j)
#pragma unroll
      for (int n = 0; n < 2; ++n) gg[j][n] = *(const f32x4*)(g + 8 * (lane + 64 * j) + 4 * n);
    int cur_seq = -1;
    half8 vn[2];
    if (it < NTOK / 8) {
#pragma unroll
      for (int j = 0; j < 2; ++j) vn[j] = *(const half8*)(X16 + (size_t)(it * 8 + wave) * 1024 + 8 * (lane + 64 * j));
    }
    for (; it < NTOK / 8; it += ogdim()) {
      const int row = it * 8 + wave;
      half8 v[2];
#pragma unroll
      for (int j = 0; j < 2; ++j) v[j] = vn[j];
      const int itn = it + ogdim();
      if (itn < NTOK / 8) {
#pragma unroll
        for (int j = 0; j < 2; ++j) vn[j] = *(const half8*)(X16 + (size_t)(itn * 8 + wave) * 1024 + 8 * (lane + 64 * j));
      }
      const int seq = seq_of_tok(row);
      if (seq != cur_seq) {
        cur_seq = seq;
        const float* ada = ADA + (layer * 6 + seq) * 3072;
#pragma unroll
        for (int j = 0; j < 2; ++j)
#pragma unroll
          for (int n = 0; n < 2; ++n) { sh[j][n] = *(const f32x4*)(ada + 8 * (lane + 64 * j) + 4 * n); scl[j][n] = *(const f32x4*)(ada + 1024 + 8 * (lane + 64 * j) + 4 * n); }
      }
      f32x4 f[2][2];
      float ss = 0.f;
#pragma unroll
      for (int j = 0; j < 2; ++j)
#pragma unroll
        for (int n = 0; n < 2; ++n)
#pragma unroll
          for (int k = 0; k < 4; ++k) { const float t = (float)v[j][4 * n + k]; f[j][n][k] = t; ss += t * t; }
#pragma unroll
      for (int o = 32; o >= 1; o >>= 1) ss += shx(ss, o, lane);
      const float rstd = rsqrtf(ss * (1.f / 1024.f) + 1e-6f);
#pragma unroll
      for (int j = 0; j < 2; ++j) {
        const f32x4 lo = f[j][0] * rstd * gg[j][0] * (scl[j][0] + 1.f) + sh[j][0];
        const f32x4 hi = f[j][1] * rstd * gg[j][1] * (scl[j][1] + 1.f) + sh[j][1];
        *(half8*)(H + (size_t)row * 1024 + 8 * (lane + 64 * j)) = pack8(lo, hi);
      }
    }
  }
  if (layer > 0) convert_layer_weights(p, layer, it, NTOK / 8, smem);
}

__device__ __forceinline__ void phase_final_norm(const Params& p) {
  const int tid = otid(); const int lane = tid & 63, wave = tid >> 6;
  const h16* X16 = (const h16*)(p.ws + OFF_R3);
  f32x4 gg[2][2];
#pragma unroll
  for (int j = 0; j < 2; ++j)
#pragma unroll
    for (int n = 0; n < 2; ++n) gg[j][n] = *(const f32x4*)(p.final_g + 8 * (lane + 64 * j) + 4 * n);
  int it = obid();
  half8 vn[2];
  if (it < NTOK / 8) {
#pragma unroll
    for (int j = 0; j < 2; ++j) vn[j] = *(const half8*)(X16 + (size_t)(it * 8 + wave) * 1024 + 8 * (lane + 64 * j));
  }
  for (; it < NTOK / 8; it += ogdim()) {
    const int row = it * 8 + wave;
    half8 v[2];
#pragma unroll
    for (int j = 0; j < 2; ++j) v[j] = vn[j];
    const int itn = it + ogdim();
    if (itn < NTOK / 8) {
#pragma unroll
      for (int j = 0; j < 2; ++j) vn[j] = *(const half8*)(X16 + (size_t)(itn * 8 + wave) * 1024 + 8 * (lane + 64 * j));
    }
    f32x4 f[2][2];
    float ss = 0.f;
#pragma unroll
    for (int j = 0; j < 2; ++j)
#pragma unroll
      for (int n = 0; n < 2; ++n)
#pragma unroll
        for (int k = 0; k < 4; ++k) { const float t = (float)v[j][4 * n + k]; f[j][n][k] = t; ss += t * t; }
#pragma unroll
    for (int o = 32; o >= 1; o >>= 1) ss += shx(ss, o, lane);
    const float rstd = rsqrtf(ss * (1.f / 1024.f) + 1e-6f);
    float* xo = p.out + (size_t)row * 1024;
#pragma unroll
    for (int j = 0; j < 2; ++j)
#pragma unroll
      for (int n = 0; n < 2; ++n) *(f32x4*)(xo + 8 * (lane + 64 * j) + 4 * n) = f[j][n] * rstd * gg[j][n];
  }
}

namespace pg8 {
constexpr int BK = 64, HALF = 128, HTB = HALF * BK * 2, STAGE_BYTES = 8 * HTB;
enum { PK_NONE = 0, PK_P32 = 1, PK_ROPE = 2 };
__device__ __forceinline__ int lds_byte(int r, int c) { const int st = (r >> 4) * 2 + (c >> 5), rr = r & 15, cc = c & 31, ob = rr * 64 + cc * 2; return st * 1024 + (ob ^ (((ob >> 9) & 1) << 5)); }
__device__ __forceinline__ void stage_rc(int b, int& R, int& C) { const int st = b / 1024, sb = b % 1024, swz = sb ^ (((sb >> 9) & 1) << 5); R = (st >> 1) * 16 + swz / 64; C = (st & 1) * 32 + (swz % 64) / 2; }
__device__ __forceinline__ int perm_row(int R, int kind) {
  if (kind == PK_P32) { const int rho = R & 31, n = rho >> 4, i = rho & 15; return (R & ~31) + 8 * (i >> 2) + 4 * n + (i & 3); }
  if (kind == PK_ROPE) { const int rho = R & 31, n = rho >> 4, i = rho & 15; return 2 * (R & ~31) + 8 * (i >> 2) + 4 * n + (i & 3); }
  return R;
}
struct Unit { const char* A; const char* B; unsigned ldb; int pkind; int kind; int pm; int pn; int aux; };
__device__ __forceinline__ void tile_of(int L, int nM, int nN, int& pm, int& pn) {
  const int nwg = nM * nN; int wgid = L;
  { const int q = nwg / 8, r = nwg % 8, xcd = wgid % 8, off = wgid / 8; wgid = (xcd < r ? xcd * (q + 1) : r * (q + 1) + (xcd - r) * q) + off; }
  const int nig = 8 * nN, gid = wgid / nig, fm = gid * 8, gsz = (nM - fm) < 8 ? (nM - fm) : 8;
  pm = fm + ((wgid % nig) % gsz); pn = (wgid % nig) / gsz;
}

template <class Epi, class Sched>
__device__ __forceinline__ void gemm_phase(LAS unsigned char* lds, const Sched& S, const Epi& E, const int tid) {
  const int wid = __builtin_amdgcn_readfirstlane(tid >> 6), lane = tid & 63, wr = wid >> 2, wc = wid & 3, fr = lane & 15, fq = lane >> 4;
  constexpr int K = 1024, nt = K / BK;
  unsigned voffA[2];
#pragma unroll
  for (int i = 0; i < 2; ++i) { int sR, sC; stage_rc(tid * 16 + i * 8192, sR, sC); voffA[i] = (unsigned)(sR * K + sC) * 2u; }
  const size_t kstep = (size_t)(BK * 2);
  const size_t hstepA = (size_t)HALF * K * 2;
  const unsigned ldsw = (unsigned)wid * 1024u;
  const int aoff = lds_byte(wr * 64 + fr, fq * 8), boff = lds_byte(wc * 32 + fr, fq * 8);
#define PG8_SA(b, h) (((b) * 2 + (h)) * HTB)
#define PG8_SB(b, h) ((4 + (b) * 2 + (h)) * HTB)
#define PG8_STAGE(bufoff, gbase, voff) do { _Pragma("unroll") for (int _i = 0; _i < 2; ++_i) \
    __builtin_amdgcn_global_load_lds((const unsigned*)((const char*)(gbase) + (voff)[_i]), (LAS unsigned*)(lds + (bufoff) + ldsw + _i * 8192), 16, 0, 0); } while (0)
#define PG8_LDA(dst, b, h) do { _Pragma("unroll") for (int m = 0; m < 4; ++m) _Pragma("unroll") for (int k = 0; k < 2; ++k) dst[m][k] = *(const LAS half8*)(lds + PG8_SA(b, h) + aoff + m * 2048 + k * 1024); } while (0)
#define PG8_LDB(dst, b, h) do { _Pragma("unroll") for (int n = 0; n < 2; ++n) _Pragma("unroll") for (int k = 0; k < 2; ++k) dst[n][k] = *(const LAS half8*)(lds + PG8_SB(b, h) + boff + n * 2048 + k * 1024); } while (0)
#define PG8_MMA(ai, bj, At, Bt) do { __builtin_amdgcn_s_setprio(1); _Pragma("unroll") for (int m = 0; m < 4; ++m) _Pragma("unroll") for (int n = 0; n < 2; ++n) _Pragma("unroll") for (int k = 0; k < 2; ++k) \
    acc[ai][bj][m][n] = __builtin_amdgcn_mfma_f32_16x16x32_f16(Bt[n][k], At[m][k], acc[ai][bj][m][n], 0, 0, 0); __builtin_amdgcn_s_setprio(0); } while (0)
#define PG8_WAIT_V(n) asm volatile("s_waitcnt vmcnt(" #n ")" ::: "memory")
#define PG8_WAIT_L(n) asm volatile("s_waitcnt lgkmcnt(" #n ")" ::: "memory")
#define PG8_BAR __builtin_amdgcn_s_barrier()
#define PG8_SCHED __builtin_amdgcn_sched_barrier(0)
  Unit cur, nxt; int ui = 0;
  if (!S.next(0, cur)) return;
  f32x4 acc[2][2][4][2];
#pragma unroll
  for (int a = 0; a < 2; ++a)
#pragma unroll
    for (int b = 0; b < 2; ++b)
#pragma unroll
      for (int m = 0; m < 4; ++m)
#pragma unroll
        for (int n = 0; n < 2; ++n) acc[a][b][m][n] = (f32x4){0.f, 0.f, 0.f, 0.f};
  half8 At[4][2], B0[2][2], B1[2][2];
  const char* cA = cur.A; const char* cB = cur.B;
  unsigned vbc[2], vbn[2];
  size_t hBc = (size_t)(cur.pkind == PK_ROPE ? 32 : HALF) * cur.ldb, hBn;
#pragma unroll
  for (int i = 0; i < 2; ++i) { int sR, sC; stage_rc(tid * 16 + i * 8192, sR, sC); vbc[i] = (unsigned)perm_row(sR, cur.pkind) * cur.ldb + (unsigned)sC * 2u; }
  PG8_STAGE(PG8_SB(0, 0), cB, vbc); PG8_STAGE(PG8_SA(0, 0), cA, voffA); PG8_STAGE(PG8_SB(0, 1), cB + hBc, vbc); PG8_STAGE(PG8_SA(0, 1), cA + hstepA, voffA);
  if (wr == 1) PG8_BAR;
  PG8_WAIT_V(4); PG8_BAR;
  PG8_STAGE(PG8_SB(1, 0), cB + kstep, vbc); PG8_STAGE(PG8_SA(1, 0), cA + kstep, voffA); PG8_STAGE(PG8_SB(1, 1), cB + hBc + kstep, vbc);
  PG8_WAIT_V(6); PG8_BAR;
  for (;;) {
    const bool has_next = S.next(ui + 1, nxt);
    const char* nA = has_next ? nxt.A : cA; const char* nB = has_next ? nxt.B : cB;
    hBn = has_next ? (size_t)(nxt.pkind == PK_ROPE ? 32 : HALF) * nxt.ldb : hBc;
#pragma unroll
    for (int i = 0; i < 2; ++i) { int sR, sC; stage_rc(tid * 16 + i * 8192, sR, sC); vbn[i] = has_next ? ((unsigned)perm_row(sR, nxt.pkind) * nxt.ldb + (unsigned)sC * 2u) : vbc[i]; }
    for (int t = 0; t < nt; t += 2) {
      const bool last = (t == nt - 2);
      const char* a1 = cA + (size_t)(t + 1) * kstep;
      const char* a2 = last ? nA : cA + (size_t)(t + 2) * kstep; const char* b2 = last ? nB : cB + (size_t)(t + 2) * kstep;
      const char* a3 = a2 + kstep; const char* b3 = b2 + kstep;
      unsigned vb[2]; vb[0] = last ? vbn[0] : vbc[0]; vb[1] = last ? vbn[1] : vbc[1];
      const size_t hb = last ? hBn : hBc;
      const bool dostage = !(last && !has_next);
      PG8_LDB(B0, 0, 0); PG8_SCHED; PG8_LDA(At, 0, 0); PG8_STAGE(PG8_SA(1, 1), a1 + hstepA, voffA);
      PG8_WAIT_L(8); PG8_BAR; PG8_WAIT_L(0); PG8_MMA(0, 0, At, B0); PG8_BAR; PG8_SCHED;
      PG8_LDB(B1, 0, 1); if (dostage) PG8_STAGE(PG8_SB(0, 0), b2, vb);
      PG8_BAR; PG8_WAIT_L(0); PG8_MMA(0, 1, At, B1); PG8_BAR;
      PG8_LDA(At, 0, 1); if (dostage) PG8_STAGE(PG8_SA(0, 0), a2, voffA);
      PG8_BAR; PG8_WAIT_L(0); PG8_MMA(1, 0, At, B0); PG8_BAR; PG8_SCHED;
      if (dostage) { PG8_STAGE(PG8_SB(0, 1), b2 + hb, vb); PG8_WAIT_V(6); } else { PG8_WAIT_V(0); }
      PG8_BAR; PG8_MMA(1, 1, At, B1); PG8_BAR;
      PG8_LDB(B0, 1, 0); PG8_SCHED; PG8_LDA(At, 1, 0); if (dostage) PG8_STAGE(PG8_SA(0, 1), a2 + hstepA, voffA);
      PG8_WAIT_L(8); PG8_BAR; PG8_WAIT_L(0); PG8_MMA(0, 0, At, B0); PG8_BAR; PG8_SCHED;
      PG8_LDB(B1, 1, 1); if (dostage) PG8_STAGE(PG8_SB(1, 0), b3, vb);
      PG8_BAR; PG8_WAIT_L(0); PG8_MMA(0, 1, At, B1); PG8_BAR;
      PG8_LDA(At, 1, 1); if (dostage) PG8_STAGE(PG8_SA(1, 0), a3, voffA);
      PG8_BAR; PG8_WAIT_L(0); PG8_MMA(1, 0, At, B0); PG8_BAR; PG8_SCHED;
      if (dostage) { PG8_STAGE(PG8_SB(1, 1), b3 + hb, vb); PG8_WAIT_V(6); } else { PG8_WAIT_V(0); }
      PG8_BAR; PG8_MMA(1, 1, At, B1); PG8_BAR;
    }
    E(acc, cur, wr, wc, fr, fq);
    if (!has_next) break;
#pragma unroll
    for (int a = 0; a < 2; ++a)
#pragma unroll
      for (int b = 0; b < 2; ++b)
#pragma unroll
        for (int m = 0; m < 4; ++m)
#pragma unroll
          for (int n = 0; n < 2; ++n) acc[a][b][m][n] = (f32x4){0.f, 0.f, 0.f, 0.f};
    cur = nxt; cA = nA; cB = nB; hBc = hBn; vbc[0] = vbn[0]; vbc[1] = vbn[1]; ++ui;
  }
  PG8_WAIT_V(0);
  if (wr == 0) PG8_BAR;
  PG8_BAR;
#undef PG8_SA
#undef PG8_SB
#undef PG8_STAGE
#undef PG8_LDA
#undef PG8_LDB
#undef PG8_MMA
#undef PG8_WAIT_V
#undef PG8_WAIT_L
#undef PG8_BAR
#undef PG8_SCHED
}
}
typedef f32x4 acc_t[2][2][4][2];


enum { UK_QK = 0, UK_Z = 1, UK_VT = 2 };
struct AttnInSched {
  const char* H; const char* W; int tok0; int S;
  __device__ __forceinline__ bool next(int i, pg8::Unit& u) const {
    const int L = i * ogdim() + obid();
    if (L >= 1280) return false;
    if (L < 896) {
      int pm, pn; pg8::tile_of(L, 32, 28, pm, pn);
      u.pm = pm; u.ldb = 2048u;
      u.A = H + (size_t)(tok0 + pm * 256) * 2048;
      if (pn < 24) {
        const int g = pn >> 3, qk = (pn >> 2) & 1, cb = pn & 3;
        u.kind = UK_QK; u.pkind = pg8::PK_ROPE; u.pn = pn; u.aux = (g * 2 + qk) * 1024 + cb * 256;
        u.B = W + (size_t)(g * 3072 + qk * 1024 + cb * 256) * 2048;
      } else {
        u.kind = UK_Z; u.pkind = pg8::PK_P32; u.pn = pn - 24; u.aux = 0;
        u.B = W + (size_t)(9216 + (pn - 24) * 256) * 2048;
      }
    } else {
      int pm, pn; pg8::tile_of(L - 896, 12, 32, pm, pn);
      const int g = pm >> 2, fb = pm & 3;
      const int d = g == 0 ? 1 : (g == 1 ? 4 : 16);
      const int m = S / d;
      const int tp0 = pn * 256;
      const int sl = tp0 / S, w = tp0 % S, r = w / m, i0 = w % m;
      u.kind = UK_VT; u.pkind = pg8::PK_P32; u.pm = fb; u.pn = pn; u.aux = g;
      u.A = W + (size_t)(g * 3072 + 2048 + fb * 256) * 2048;
      u.B = H + (size_t)(tok0 + sl * S + i0 * d + r) * 2048;
      u.ldb = (unsigned)d * 2048u;
    }
    return true;
  }
};
struct AttnInEpi {
  h16* QK; h16* VT; h16* ZC; const float4* ROPE; int S;
  __device__ __forceinline__ void operator()(const acc_t& acc, const pg8::Unit& u, int wr, int wc, int fr, int fq) const {
    if (u.kind == UK_QK) {
      const float qs = ((u.aux >> 10) & 1) ? 1.f : 0.125f * 1.4426950408889634f;
      const int e0 = 8 * fq;
      const int tl0 = u.pm * 256 + wr * 64 + fr;
      const int ib = (((tl0) & (S - 1)) * 32 + e0) >> 1, ir = (16 * 32 + e0) >> 1;
      float c[8], sn[8], rc[8], rs[8];
#pragma unroll
      for (int k = 0; k < 4; ++k) {
        const float4 bv = ROPE[ib + k], rv = ROPE[ir + k];
        c[2 * k] = bv.x; sn[2 * k] = bv.y; c[2 * k + 1] = bv.z; sn[2 * k + 1] = bv.w;
        rc[2 * k] = rv.x; rs[2 * k] = rv.y; rc[2 * k + 1] = rv.z; rs[2 * k + 1] = rv.w;
      }
#pragma unroll
      for (int ai = 0; ai < 2; ++ai) {
#pragma unroll
        for (int m = 0; m < 4; ++m) {
          const int tl = tl0 + ai * 128 + m * 16;
          half8 o1, o2;
#pragma unroll
          for (int n = 0; n < 2; ++n) {
            const f32x4 t1 = acc[ai][0][m][n], t2 = acc[ai][1][m][n];
#pragma unroll
            for (int j = 0; j < 4; ++j) {
              o1[4 * n + j] = (h16)((t1[j] * c[4 * n + j] - t2[j] * sn[4 * n + j]) * qs);
              o2[4 * n + j] = (h16)((t2[j] * c[4 * n + j] + t1[j] * sn[4 * n + j]) * qs);
            }
          }
          h16* dst = QK + (size_t)tl * 6144 + u.aux + 64 * wc + e0;
          *(half8*)dst = o1;
          *(half8*)(dst + 32) = o2;
          const int nrot = (m < 3) ? 1 : (ai == 0 ? 5 : 0);
#pragma unroll
          for (int k = 0; k < nrot; ++k)
#pragma unroll
            for (int j = 0; j < 8; ++j) { const float cn = c[j] * rc[j] - sn[j] * rs[j], sx = sn[j] * rc[j] + c[j] * rs[j]; c[j] = cn; sn[j] = sx; }
        }
      }
    } else if (u.kind == UK_Z) {
#pragma unroll
      for (int ai = 0; ai < 2; ++ai)
#pragma unroll
        for (int m = 0; m < 4; ++m) {
          const int tl = u.pm * 256 + ai * 128 + wr * 64 + m * 16 + fr;
#pragma unroll
          for (int bj = 0; bj < 2; ++bj) {
            f32x4 a = acc[ai][bj][m][0], b = acc[ai][bj][m][1];
#pragma unroll
            for (int j = 0; j < 4; ++j) { a[j] = silu_f(a[j]); b[j] = silu_f(b[j]); }
            *(half8*)(ZC + (size_t)tl * 1024 + u.pn * 256 + bj * 128 + wc * 32 + 8 * fq) = pack8(a, b);
          }
        }
    } else {
#pragma unroll
      for (int ai = 0; ai < 2; ++ai)
#pragma unroll
        for (int m = 0; m < 4; ++m) {
          const int f = u.pm * 256 + ai * 128 + wr * 64 + m * 16 + fr;
#pragma unroll
          for (int bj = 0; bj < 2; ++bj)
            *(half8*)(VT + ((size_t)u.aux * 1024 + f) * 8192 + u.pn * 256 + bj * 128 + wc * 32 + 8 * fq) = pack8(acc[ai][bj][m][0], acc[ai][bj][m][1]);
        }
    }
  }
};
__device__ __forceinline__ void phase_attn_in(const Params& p, int chunk, char* smem) {
  const int tid = otid();
  AttnInSched S; S.H = p.ws + OFF_R0; S.W = p.ws + OFF_W + WA_IN * 2; S.tok0 = chunk * 8192; S.S = chunk < 2 ? 8192 : 4096;
  AttnInEpi E; E.QK = (h16*)(p.ws + OFF_QK); E.VT = (h16*)(p.ws + OFF_VT); E.ZC = (h16*)(p.ws + OFF_ZC); E.ROPE = (const float4*)(p.ws + OFF_ROPE); E.S = S.S;
  pg8::gemm_phase(( LAS unsigned char*)smem, S, E, tid);
}

struct PlainSched {
  const char* A; const char* W; int nN; int pkind;
  __device__ __forceinline__ bool next(int i, pg8::Unit& u) const {
    const int L = i * ogdim() + obid();
    if (L >= 128 * nN) return false;
    int pm, pn; pg8::tile_of(L, 128, nN, pm, pn);
    u.pm = pm; u.pn = pn; u.ldb = 2048u; u.kind = 0; u.pkind = pkind; u.aux = 0;
    u.A = A + (size_t)pm * 256 * 2048; u.B = W + (size_t)pn * 256 * 2048;
    return true;
  }
};
struct OutEpi {
  const float* xp; const float* xs; const h16* x16in; h16* x16out; const float* ADA; int layer;
  __device__ __forceinline__ void operator()(const acc_t& acc, const pg8::Unit& u, int wr, int wc, int fr, int fq) const {
    const int seq = seq_of_tok(u.pm * 256);
    const float* gate = ADA + (layer * 6 + seq) * 3072 + 2048;
    const int col0 = u.pn * 256 + wc * 32 + 8 * fq;
    f32x4 gv[2][2];
#pragma unroll
    for (int bj = 0; bj < 2; ++bj)
#pragma unroll
      for (int n = 0; n < 2; ++n) gv[bj][n] = *(const f32x4*)(gate + col0 + bj * 128 + 4 * n);
    const int row0 = u.pm * 256 + wr * 64 + fr;
    if (layer == 0) {
      const float* xbase = (row0 < 16384 ? xp : xs - (size_t)16384 * 1024);
      f32x4 xv[2][2], xn[2][2];
#pragma unroll
      for (int bj = 0; bj < 2; ++bj)
#pragma unroll
        for (int n = 0; n < 2; ++n) xv[bj][n] = *(const f32x4*)(xbase + (size_t)row0 * 1024 + col0 + bj * 128 + 4 * n);
#pragma unroll
      for (int k = 0; k < 8; ++k) {
        const int ai = k >> 2, m = k & 3;
        const int row = row0 + ai * 128 + m * 16;
        if (k < 7) {
          const int rn = row0 + ((k + 1) >> 2) * 128 + ((k + 1) & 3) * 16;
#pragma unroll
          for (int bj = 0; bj < 2; ++bj)
#pragma unroll
            for (int n = 0; n < 2; ++n) xn[bj][n] = *(const f32x4*)(xbase + (size_t)rn * 1024 + col0 + bj * 128 + 4 * n);
        }
#pragma unroll
        for (int bj = 0; bj < 2; ++bj)
          *(half8*)(x16out + (size_t)row * 1024 + col0 + bj * 128) = pack8(xv[bj][0] + gv[bj][0] * acc[ai][bj][m][0], xv[bj][1] + gv[bj][1] * acc[ai][bj][m][1]);
#pragma unroll
        for (int bj = 0; bj < 2; ++bj)
#pragma unroll
          for (int n = 0; n < 2; ++n) xv[bj][n] = xn[bj][n];
        asm volatile("" ::: "memory");
      }
    } else {
      half8 xv[2], xn[2];
#pragma unroll
      for (int bj = 0; bj < 2; ++bj) xv[bj] = *(const half8*)(x16in + (size_t)row0 * 1024 + col0 + bj * 128);
#pragma unroll
      for (int k = 0; k < 8; ++k) {
        const int ai = k >> 2, m = k & 3;
        const int row = row0 + ai * 128 + m * 16;
        if (k < 7) {
          const int rn = row0 + ((k + 1) >> 2) * 128 + ((k + 1) & 3) * 16;
#pragma unroll
          for (int bj = 0; bj < 2; ++bj) xn[bj] = *(const half8*)(x16in + (size_t)rn * 1024 + col0 + bj * 128);
        }
#pragma unroll
        for (int bj = 0; bj < 2; ++bj) {
          f32x4 lo, hi;
#pragma unroll
          for (int j = 0; j < 4; ++j) { lo[j] = (float)xv[bj][j]; hi[j] = (float)xv[bj][4 + j]; }
          *(half8*)(x16out + (size_t)row * 1024 + col0 + bj * 128) = pack8(lo + gv[bj][0] * acc[ai][bj][m][0], hi + gv[bj][1] * acc[ai][bj][m][1]);
        }
#pragma unroll
        for (int bj = 0; bj < 2; ++bj) xv[bj] = xn[bj];
        asm volatile("" ::: "memory");
      }
    }
  }
};
__device__ __forceinline__ void phase_out_gemm(const Params& p, int layer, const char* A, const char* Wt, char* smem) {
  const int tid = otid();
  PlainSched S; S.A = A; S.W = Wt; S.nN = 4; S.pkind = pg8::PK_P32;
  OutEpi E; E.xp = p.x_prompt; E.xs = p.x_sample; E.x16in = (const h16*)p.out; E.x16out = (layer == 3) ? (h16*)(p.ws + OFF_R3) : (h16*)p.out;
  E.ADA = (const float*)(p.ws + OFF_ADA); E.layer = layer;
  pg8::gemm_phase((LAS unsigned char*)smem, S, E, tid);
}

struct SsmInEpi {
  h16* U; h16* Z;
  __device__ __forceinline__ void operator()(const acc_t& acc, const pg8::Unit& u, int wr, int wc, int fr, int fq) const {
    const bool isz = u.pn >= 4;
    h16* dstb = (isz ? Z : U) + (u.pn & 3) * 256 + wc * 32 + 8 * fq;
#pragma unroll
    for (int ai = 0; ai < 2; ++ai)
#pragma unroll
      for (int m = 0; m < 4; ++m) {
        const int row = u.pm * 256 + ai * 128 + wr * 64 + m * 16 + fr;
#pragma unroll
        for (int bj = 0; bj < 2; ++bj) {
          f32x4 a = acc[ai][bj][m][0], b = acc[ai][bj][m][1];
          if (isz) {
#pragma unroll
            for (int j = 0; j < 4; ++j) { a[j] = silu_f(a[j]); b[j] = silu_f(b[j]); }
          }
          *(half8*)(dstb + (size_t)row * 1024 + bj * 128) = pack8(a, b);
        }
      }
  }
};
__device__ __forceinline__ void phase_ssm_in(const Params& p, char* smem) {
  const int tid = otid();
  PlainSched S; S.A = p.ws + OFF_R0; S.W = p.ws + OFF_W + WS_IN * 2; S.nN = 8; S.pkind = pg8::PK_P32;
  SsmInEpi E; E.U = (h16*)(p.ws + OFF_R1); E.Z = (h16*)(p.ws + OFF_R2);
  pg8::gemm_phase((LAS unsigned char*)smem, S, E, tid);
}

struct GluEpi {
  const h16* G; const h16* Z; h16* Y2;
  __device__ __forceinline__ void operator()(const acc_t& acc, const pg8::Unit& u, int wr, int wc, int fr, int fq) const {
    const size_t o0 = (size_t)(u.pm * 256 + wr * 64 + fr) * 1024 + u.pn * 256 + wc * 32 + 8 * fq;
    half8 gv[2], zv[2], gn[2], zn[2];
#pragma unroll
    for (int bj = 0; bj < 2; ++bj) { gv[bj] = *(const half8*)(G + o0 + bj * 128); zv[bj] = *(const half8*)(Z + o0 + bj * 128); }
#pragma unroll
    for (int ai = 0; ai < 2; ++ai)
#pragma unroll
      for (int m = 0; m < 4; ++m) {
        const size_t orow = o0 + (size_t)(ai * 128 + m * 16) * 1024;
        if (ai * 4 + m < 7) {
          const size_t onx = o0 + (size_t)(((ai * 4 + m + 1) >> 2) * 128 + ((ai * 4 + m + 1) & 3) * 16) * 1024;
#pragma unroll
          for (int bj = 0; bj < 2; ++bj) { gn[bj] = *(const half8*)(G + onx + bj * 128); zn[bj] = *(const half8*)(Z + onx + bj * 128); }
        }
#pragma unroll
        for (int bj = 0; bj < 2; ++bj) {
          const f32x4 a = acc[ai][bj][m][0], b = acc[ai][bj][m][1];
          half8 r;
#pragma unroll
          for (int j = 0; j < 4; ++j) {
            r[j] = (h16)((float)gv[bj][j] * sigmoid_f(a[j]) * (float)zv[bj][j]);
            r[4 + j] = (h16)((float)gv[bj][4 + j] * sigmoid_f(b[j]) * (float)zv[bj][4 + j]);
          }
          *(half8*)(Y2 + orow + bj * 128) = r;
        }
#pragma unroll
        for (int bj = 0; bj < 2; ++bj) { gv[bj] = gn[bj]; zv[bj] = zn[bj]; }
        asm volatile("" ::: "memory");
      }
  }
};
__device__ __forceinline__ void phase_ssm_glu(const Params& p, char* smem) {
  const int tid = otid();
  PlainSched S; S.A = p.ws + OFF_R0; S.W = p.ws + OFF_W + WS_GLU * 2; S.nN = 4; S.pkind = pg8::PK_P32;
  GluEpi E; E.G = (const h16*)(p.ws + OFF_R0); E.Z = (const h16*)(p.ws + OFF_R2); E.Y2 = (h16*)(p.ws + OFF_R1);
  pg8::gemm_phase((LAS unsigned char*)smem, S, E, tid);
}

__device__ __forceinline__ void sub_barrier(volatile LAS unsigned* cnt, unsigned& target, int lane) {
  asm volatile("s_waitcnt vmcnt(0) lgkmcnt(0)" ::: "memory");
  if (lane == 0) {
    __hip_atomic_fetch_add((LAS unsigned*)cnt, 1u, __ATOMIC_RELAXED, __HIP_MEMORY_SCOPE_WORKGROUP);
    while (__hip_atomic_load((LAS unsigned*)cnt, __ATOMIC_RELAXED, __HIP_MEMORY_SCOPE_WORKGROUP) < target) __builtin_amdgcn_s_sleep(1);
  }
  target += 4u;
  asm volatile("" ::: "memory");
}
__device__ __forceinline__ void phase_attn(const Params& p, int chunk, char* smem) {
  const int tid0 = otid(), lane = tid0 & 63, wave8 = tid0 >> 6;
  const int sub = wave8 >> 2, wave = wave8 & 3, tid = tid0 & 255;
  const h16* QK = (const h16*)(p.ws + OFF_QK);
  const h16* VT = (const h16*)(p.ws + OFF_VT);
  h16* O3 = (h16*)(p.ws + OFF_O3);
  float* LSE = (float*)(p.ws + OFF_LSE);
  const int S = chunk < 2 ? 8192 : 4096;
  constexpr int KROW = 72, VROW = 264;
  h16* Ks = (h16*)(smem + sub * ATT_LDS);
  h16* Vs = (h16*)(smem + sub * ATT_LDS + 256 * KROW * 2);
  volatile LAS unsigned* cnt = (volatile LAS unsigned*)(smem + 2 * ATT_LDS) + sub * 32;
  if (tid0 < 64) ((volatile LAS unsigned*)(smem + 2 * ATT_LDS))[tid0] = 0u;
  __syncthreads();
  unsigned target = 4u;
  const int n = lane & 31, hh = lane >> 5;
  const int qw = wave * 32;
  const int NIT = 3 * 64 * 8;
  auto decode = [&](int it0, int& hd, int& g, int& d, int& m, int& sl, int& r, int& i0) {
    const int it = it0 * 2 + sub;
    hd = it & 15; const int rest = it >> 4;
    g = rest / 64; const int blk = rest % 64;
    d = g == 0 ? 1 : (g == 1 ? 4 : 16);
    m = S / d;
    const int tp0 = blk * 128;
    sl = tp0 / S; const int w = tp0 % S; r = w / m; i0 = w % m;
  };
  half8 kreg[8], vreg[8], qpre[4];
  auto load_kq = [&](int it0) {
    int hd, g, d, m, sl, r, i0; decode(it0, hd, g, d, m, sl, r, i0);
#pragma unroll
    for (int itx = 0; itx < 8; ++itx) {
      const int idx = tid + 256 * itx;
      const int row = idx >> 3, ch = idx & 7;
      const int kj = i0 - 64 + row;
      half8 v = zero8();
      if (kj >= 0 && kj < m) v = *(const half8*)(QK + (size_t)(sl * S + kj * d + r) * 6144 + (g * 2 + 1) * 1024 + hd * 64 + ch * 8);
      kreg[itx] = v;
    }
  };
  auto load_v = [&](int it0) {
    int hd, g, d, m, sl, r, i0; decode(it0, hd, g, d, m, sl, r, i0);
    const h16* qp = QK + (size_t)(sl * S + (i0 + qw + n) * d + r) * 6144 + (g * 2) * 1024 + hd * 64 + hh * 8;
#pragma unroll
    for (int ks = 0; ks < 4; ++ks) qpre[ks] = *(const half8*)(qp + ks * 16);
#pragma unroll
    for (int itx = 0; itx < 8; ++itx) {
      const int idx = tid + 256 * itx;
      const int row = idx >> 5, ch = idx & 31;
      const int kj = i0 - 64 + ch * 8;
      half8 v = zero8();
      if (kj >= 0 && kj < m) v = *(const half8*)(VT + ((size_t)g * 1024 + hd * 64 + row) * 8192 + sl * S + r * m + kj);
      vreg[itx] = v;
    }
  };
  int it0 = obid();
  if (it0 < NIT) { load_kq(it0); load_v(it0); }
  for (; it0 < NIT; it0 += ogdim()) {
    int hd, g, d, m, sl, r, i0; decode(it0, hd, g, d, m, sl, r, i0);
    const int itn = it0 + ogdim();
#pragma unroll
    for (int itx = 0; itx < 8; ++itx) { const int idx = tid + 256 * itx; *(half8*)(Ks + (idx >> 3) * KROW + (idx & 7) * 8) = kreg[itx]; }
#pragma unroll
    for (int itx = 0; itx < 8; ++itx) { const int idx = tid + 256 * itx; *(half8*)(Vs + (idx >> 5) * VROW + (idx & 31) * 8) = vreg[itx]; }
    sub_barrier(cnt, target, lane);
    if (itn < NIT) load_kq(itn);
    f32x16 sc[5];
#pragma unroll
    for (int kb = 0; kb < 5; ++kb) {
#pragma unroll
      for (int i = 0; i < 16; ++i) sc[kb][i] = 0.f;
#pragma unroll
      for (int ks = 0; ks < 4; ++ks) {
        half8 kf = *(const half8*)(Ks + (qw + kb * 32 + n) * KROW + ks * 16 + hh * 8);
        sc[kb] = MFMA32(kf, qpre[ks], sc[kb]);
      }
      __builtin_amdgcn_sched_barrier(0);
    }
    if (itn < NIT) load_v(itn);
    const int qi = i0 + qw + n;
    const bool edge = (i0 + qw < 64) || (i0 + qw + 96 > m);
    if (edge) {
      const int lo = max(qi - 64, 0), hi = min(qi + 64, m - 1);
#pragma unroll
      for (int kb = 0; kb < 5; ++kb)
#pragma unroll
        for (int i = 0; i < 16; ++i) {
          int kj = i0 + qw - 64 + kb * 32 + 8 * (i >> 2) + 4 * hh + (i & 3);
          sc[kb][i] = (kj >= lo && kj <= hi) ? sc[kb][i] : -1e30f;
        }
    } else {
      const int nn0 = n - 4 * hh;
#pragma unroll
      for (int i = 0; i < 16; ++i) {
        const int ci = 8 * (i >> 2) + (i & 3);
        sc[0][i] = (ci >= nn0) ? sc[0][i] : -1e30f;
        sc[4][i] = (ci <= nn0) ? sc[4][i] : -1e30f;
      }
    }
    float mx = -1e30f;
#pragma unroll
    for (int kb = 0; kb < 5; ++kb)
#pragma unroll
      for (int i = 0; i < 16; ++i) mx = fmaxf(mx, sc[kb][i]);
    mx = fmaxf(mx, shx(mx, 32, lane));
    float sum = 0.f;
    half8 pfa[5][2];
#pragma unroll
    for (int kb = 0; kb < 5; ++kb)
#pragma unroll
      for (int i = 0; i < 16; ++i) {
        float pv = __builtin_amdgcn_exp2f(sc[kb][i] - mx);
        pfa[kb][i >> 3][i & 7] = (h16)pv;
        sum += pv;
      }
    sum += shx(sum, 32, lane);
    asm volatile("" : "+v"(pfa[0][0]), "+v"(pfa[0][1]), "+v"(pfa[1][0]), "+v"(pfa[1][1]), "+v"(pfa[2][0]), "+v"(pfa[2][1]), "+v"(pfa[3][0]), "+v"(pfa[3][1]), "+v"(pfa[4][0]), "+v"(pfa[4][1]));
    f32x16 oacc[2];
#pragma unroll
    for (int mb = 0; mb < 2; ++mb)
#pragma unroll
      for (int i = 0; i < 16; ++i) oacc[mb][i] = 0.f;
#pragma unroll
    for (int kb = 0; kb < 5; ++kb)
#pragma unroll
      for (int s2 = 0; s2 < 2; ++s2) {
        const half8 pf = pfa[kb][s2];
#pragma unroll
        for (int mb = 0; mb < 2; ++mb) {
          const h16* vp = Vs + (mb * 32 + n) * VROW + qw + kb * 32 + 16 * s2 + 4 * hh;
          half4 v0 = *(const half4*)(vp), v1 = *(const half4*)(vp + 8);
          half8 vf = {v0[0], v0[1], v0[2], v0[3], v1[0], v1[1], v1[2], v1[3]};
          oacc[mb] = MFMA32(vf, pf, oacc[mb]);
        }
        __builtin_amdgcn_sched_barrier(0);
      }
    float inv = 1.f / sum;
    int tl = sl * S + qi * d + r;
    h16* op = O3 + ((size_t)g * 8192 + tl) * 1024 + hd * 64;
#pragma unroll
    for (int mb = 0; mb < 2; ++mb)
#pragma unroll
      for (int pq = 0; pq < 2; ++pq) {
        union { half4 h; int w[2]; } he, ho, rv;
#pragma unroll
        for (int rr = 0; rr < 4; ++rr) { he.h[rr] = (h16)(oacc[mb][8 * pq + rr] * inv); ho.h[rr] = (h16)(oacc[mb][8 * pq + 4 + rr] * inv); }
        const int s0 = hh ? he.w[0] : ho.w[0], s1 = hh ? he.w[1] : ho.w[1];
        rv.w[0] = __builtin_amdgcn_ds_bpermute((lane ^ 32) << 2, s0);
        rv.w[1] = __builtin_amdgcn_ds_bpermute((lane ^ 32) << 2, s1);
        const half4 lo = hh ? rv.h : he.h, hi = hh ? ho.h : rv.h;
        const half8 o = {lo[0], lo[1], lo[2], lo[3], hi[0], hi[1], hi[2], hi[3]};
        *(half8*)(op + mb * 32 + 8 * (2 * pq + hh)) = o;
      }
    if (hh == 0) LSE[((size_t)g * 8192 + tl) * 16 + hd] = (mx + __builtin_amdgcn_logf(sum)) * 0.6931471805599453f;
    sub_barrier(cnt, target, lane);
  }
  __syncthreads();
}

__device__ __forceinline__ void phase_attn_combine(const Params& p, int chunk) {
  const h16* O3 = (const h16*)(p.ws + OFF_O3);
  const float* LSE = (const float*)(p.ws + OFF_LSE);
  const h16* ZC = (const h16*)(p.ws + OFF_ZC);
  h16* YA = (h16*)(p.ws + OFF_R0) + (size_t)chunk * 8192 * 1024;
  for (int it = obid(); it < 8192 * 128 / NT; it += ogdim()) {
    int idx = it * NT + otid();
    int tl = idx >> 7, c8 = idx & 127;
    int hd = c8 >> 3;
    float l0 = LSE[((size_t)0 * 8192 + tl) * 16 + hd], l1 = LSE[((size_t)1 * 8192 + tl) * 16 + hd], l2 = LSE[((size_t)2 * 8192 + tl) * 16 + hd];
    float mx = fmaxf(l0, fmaxf(l1, l2));
    float w0 = __expf(l0 - mx), w1 = __expf(l1 - mx), w2 = __expf(l2 - mx);
    float inv = __builtin_amdgcn_rcpf(w0 + w1 + w2);
    w0 *= inv; w1 *= inv; w2 *= inv;
    size_t off = (size_t)tl * 1024 + c8 * 8;
    half8 a = *(const half8*)(O3 + off), b = *(const half8*)(O3 + (size_t)8192 * 1024 + off), c = *(const half8*)(O3 + (size_t)2 * 8192 * 1024 + off);
    half8 z = *(const half8*)(ZC + off);
    half8 o;
#pragma unroll
    for (int j = 0; j < 8; ++j) o[j] = (h16)((w0 * (float)a[j] + w1 * (float)b[j] + w2 * (float)c[j]) * (float)z[j]);
    *(half8*)(YA + off) = o;
  }
}

struct ScanPar { float lbr[2], lbi[2], nlbi[2], dt; half8 Bop[4]; half8 Cop[4]; };
__device__ __forceinline__ void scan_setup(const Params& p, int j, int dir, int g, int lane, bool needC, ScanPar& P) {
  const int n = lane & 31, hh = lane >> 5;
  const size_t pbase = (((size_t)j * 2 + dir) * 64 + g);
  const float dt = __expf(p.log_dt[pbase]);
  P.dt = dt;
  float fr[2], fi[2];
#pragma unroll
  for (int s = 0; s < 2; ++s) {
    int st = n + 32 * s;
    float lre = fminf(p.lam_re[pbase * 64 + st], -1e-4f);
    float lim = p.lam_im[pbase * 64 + st];
    float zr = lre * dt, zi = lim * dt;
    float er = __expf(zr);
    float sn, cs, snh, csh;
    sincos_acc(zi, sn, cs);
    sincos_acc(0.5f * zi, snh, csh);
    P.lbr[s] = er * cs;
    P.lbi[s] = er * sn;
    P.nlbi[s] = -P.lbi[s];
    float nr = expm1f(zr) * cs - 2.f * snh * snh, ni = er * sn;
    float den = 1.f / (zr * zr + zi * zi);
    fr[s] = (nr * zr + ni * zi) * den;
    fi[s] = (ni * zr - nr * zi) * den;
  }
#pragma unroll
  for (int s = 0; s < 2; ++s) {
    int st = n + 32 * s;
    const float* br = p.b_re + (pbase * 64 + st) * 16 + 8 * hh;
    const float* bi = p.b_im + (pbase * 64 + st) * 16 + 8 * hh;
#pragma unroll
    for (int jj = 0; jj < 8; ++jj) {
      float a = br[jj], b = bi[jj];
      P.Bop[2 * s][jj] = (h16)(fr[s] * a - fi[s] * b);
      P.Bop[2 * s + 1][jj] = (h16)(fr[s] * b + fi[s] * a);
    }
  }
  if (needC) {
    int ch = lane & 15, qd = lane >> 4;
#pragma unroll
    for (int kb = 0; kb < 4; ++kb)
#pragma unroll
      for (int jj = 0; jj < 8; ++jj) {
        int kap = 32 * kb + 8 * qd + jj;
        int np = kap >> 2, which = kap & 3;
        int st = np + 32 * (which >> 1);
        size_t ci = (pbase * 16 + ch) * 64 + st;
        P.Cop[kb][jj] = (which & 1) ? (h16)(-p.c_im[ci]) : (h16)(p.c_re[ci]);
      }
  }
}
template <int MODE>
__device__ __forceinline__ void scan_run(const Params& p, const ScanPar& P, const int dir, const int g, const int sp, const int lane, h16* X, const f32x4 dsk) {
  const int n = lane & 31, hh = lane >> 5;
  const h16* U = (const h16*)(p.ws + OFF_R1);
  h16* Y = (h16*)(p.ws + OFF_R0);
  float4* ENDS = (float4*)(p.ws + OFF_ENDS);
  constexpr int XROW = 136;
  const int pairtok = sp * 512;
  const int S = pairtok < 16384 ? 8192 : 4096;
  const int seqstart = pairtok < 16384 ? (pairtok & ~8191) : 16384 + ((pairtok - 16384) & ~4095);
  const int segt = ((pairtok - seqstart) >> 8) + hh;
  const int nseg = S >> 8;
  const int segstart = seqstart + segt * 256;
  const int gseg0 = seqstart >> 8;
  float xr0 = 0.f, xi0 = 0.f, xr1 = 0.f, xi1 = 0.f;
  if (MODE != 0) {
    float pr0 = P.lbr[0], pi0 = P.lbi[0], pr1 = P.lbr[1], pi1 = P.lbi[1];
#pragma unroll
    for (int q = 0; q < 8; ++q) {
      float a = pr0 * pr0 - pi0 * pi0, b = 2.f * pr0 * pi0; pr0 = a; pi0 = b;
      float c = pr1 * pr1 - pi1 * pi1, dd = 2.f * pr1 * pi1; pr1 = c; pi1 = dd;
    }
    const float4* eb = ENDS + ((size_t)(dir * 64 + g) * 128) * 32;
    int cnt = dir == 0 ? segt : (nseg - 1 - segt);
    for (int c = 0; c < cnt; ++c) {
      int sg = dir == 0 ? c : (nseg - 1 - c);
      float4 e = eb[(size_t)(gseg0 + sg) * 32 + n];
      float a = pr0 * xr0 - pi0 * xi0 + e.x, b = pr0 * xi0 + pi0 * xr0 + e.y;
      xr0 = a; xi0 = b;
      float c2 = pr1 * xr1 - pi1 * xi1 + e.z, d2 = pr1 * xi1 + pi1 * xr1 + e.w;
      xr1 = c2; xi1 = d2;
    }
  }
  const int am = lane & 31;
  const int ahalf = (am >> 2) & 1, astep = ((am >> 3) << 2) | (am & 3);
  const int asegstart = seqstart + (((pairtok - seqstart) >> 8) + ahalf) * 256;
  const h16* ubase = U + g * 16 + 8 * (lane >> 5);
  auto utok = [&](int ci) { int tau = ci * 16 + astep; return dir ? (asegstart + 255 - tau) : (asegstart + tau); };
  half8 unext = *(const half8*)(ubase + (size_t)utok(0) * 1024);
  for (int ci = 0; ci < 16; ++ci) {
    half8 ua = unext;
    if (ci + 1 < 16) unext = *(const half8*)(ubase + (size_t)utok(ci + 1) * 1024);
    const int trow = lane & 15, qd = lane >> 4;
    half4 uo[2]; unsigned yp[2][2];
    if (MODE == 2) {
#pragma unroll
      for (int h2 = 0; h2 < 2; ++h2) {
        int sst = seqstart + (((pairtok - seqstart) >> 8) + h2) * 256;
        int tau = ci * 16 + trow;
        int tok = dir ? (sst + 255 - tau) : (sst + tau);
        const size_t off = (size_t)tok * 1024 + g * 16 + 4 * qd;
        uo[h2] = *(const half4*)(U + off);
        yp[h2][0] = __hip_atomic_load((unsigned*)(Y + off), __ATOMIC_RELAXED, __HIP_MEMORY_SCOPE_AGENT);
        yp[h2][1] = __hip_atomic_load((unsigned*)(Y + off) + 1, __ATOMIC_RELAXED, __HIP_MEMORY_SCOPE_AGENT);
      }
    }
    f32x16 bu[4];
#pragma unroll
    for (int nb = 0; nb < 4; ++nb) {
      f32x16 z;
#pragma unroll
      for (int i = 0; i < 16; ++i) z[i] = 0.f;
      bu[nb] = MFMA32(ua, P.Bop[nb], z);
    }
#pragma unroll
    for (int i = 0; i < 16; ++i) {
      float a = afma(P.lbr[0], xr0, afma(P.nlbi[0], xi0, bu[0][i]));
      float b = afma(P.lbr[0], xi0, afma(P.lbi[0], xr0, bu[1][i]));
      xr0 = a; xi0 = b;
      float c = afma(P.lbr[1], xr1, afma(P.nlbi[1], xi1, bu[2][i]));
      float dd = afma(P.lbr[1], xi1, afma(P.lbi[1], xr1, bu[3][i]));
      xr1 = c; xi1 = dd;
      asm volatile("" : "+v"(xr0), "+v"(xi0), "+v"(xr1), "+v"(xi1));
      if (MODE != 0) {
        half4 hv = {(h16)xr0, (h16)xi0, (h16)xr1, (h16)xi1};
        *(half4*)(X + (hh * 16 + i) * XROW + 4 * n) = hv;
      }
    }
    if (MODE != 0) {
      asm volatile("s_waitcnt lgkmcnt(0)" ::: "memory");
#pragma unroll
      for (int h2 = 0; h2 < 2; ++h2) {
        f32x4 y = {0.f, 0.f, 0.f, 0.f};
#pragma unroll
        for (int kb = 0; kb < 4; ++kb) {
          half8 xb = *(const half8*)(X + (h2 * 16 + trow) * XROW + 32 * kb + 8 * qd);
          y = MFMA16(P.Cop[kb], xb, y);
        }
        int sst = seqstart + (((pairtok - seqstart) >> 8) + h2) * 256;
        int tau = ci * 16 + trow;
        int tok = dir ? (sst + 255 - tau) : (sst + tau);
        h16* dst = Y + (size_t)tok * 1024 + g * 16 + 4 * qd;
        if (MODE == 1) {
          half4 o = {(h16)(y[0] * P.dt), (h16)(y[1] * P.dt), (h16)(y[2] * P.dt), (h16)(y[3] * P.dt)};
          *(half4*)dst = o;
        } else {
          union { unsigned w[2]; half4 h; } cv; cv.w[0] = yp[h2][0]; cv.w[1] = yp[h2][1];
          half4 o;
#pragma unroll
          for (int k = 0; k < 4; ++k) o[k] = (h16)gelu_tanh(dsk[k] * (float)uo[h2][k] + (float)cv.h[k] + y[k] * P.dt);
          *(half4*)dst = o;
        }
      }
      asm volatile("s_waitcnt lgkmcnt(0)" ::: "memory");
    }
  }
  if (MODE == 0) ENDS[((size_t)(dir * 64 + g) * 128 + (segstart >> 8)) * 32 + n] = make_float4(xr0, xi0, xr1, xi1);
}
__device__ __forceinline__ void phase_scan1(const Params& p, int j, char* smem) {
  const int tid = otid(), lane = tid & 63, wave = tid >> 6;
  const int nwaves = ogdim() * 8;
  const int wpc = nwaves >> 7;
  const int wglob = obid() * 8 + wave;
  if (wglob < wpc * 128) {
    const int combo = wglob & 127, slot = wglob >> 7;
    const int dir = combo & 1, g = combo >> 1;
    ScanPar P; scan_setup(p, j, dir, g, lane, false, P);
    const f32x4 dz = {0.f, 0.f, 0.f, 0.f};
    for (int sp = slot; sp < 64; sp += wpc) scan_run<0>(p, P, dir, g, sp, lane, (h16*)smem, dz);
  }
}
__device__ __forceinline__ void phase_scan2(const Params& p, int j, char* smem) {
  const int tid = otid(), lane = tid & 63, wave = tid >> 6;
  h16* X = (h16*)smem + wave * 32 * 136;
  const int nwaves = ogdim() * 8;
  const int wpg = nwaves >> 6;
  const int wglob = obid() * 8 + wave;
  if (wglob < wpg * 64) {
    const int g = wglob & 63, slot = wglob >> 6;
    ScanPar P0, P1;
    scan_setup(p, j, 0, g, lane, true, P0);
    scan_setup(p, j, 1, g, lane, true, P1);
    const f32x4 dsk = *(const f32x4*)(p.ssm_d + j * 1024 + g * 16 + 4 * (lane >> 4));
    for (int sp = slot; sp < 64; sp += wpg) {
      scan_run<1>(p, P0, 0, g, sp, lane, X, dsk);
      asm volatile("s_waitcnt vmcnt(0)" ::: "memory");
      scan_run<2>(p, P1, 1, g, sp, lane, X, dsk);
    }
  }
}

#define XB_TMO      128
#define XB_XCNT(j)  (256  + 64 * (j))
#define XB_XSUB(j)  (1280 + 64 * (j))
#define XB_XGEN(j)  (2304 + 64 * (j))
#define XB_TOP      3328
#define XB_TOPGEN   3392
#define XCD_BAR_WORDS 3456
#define XB_SPIN_CAP (1u << 22)
__device__ __forceinline__ unsigned xb_ld(unsigned* p)              { return __hip_atomic_load(p, __ATOMIC_RELAXED, __HIP_MEMORY_SCOPE_AGENT); }
__device__ __forceinline__ unsigned xb_add(unsigned* p, unsigned v) { return __hip_atomic_fetch_add(p, v, __ATOMIC_RELAXED, __HIP_MEMORY_SCOPE_AGENT); }
__device__ __forceinline__ unsigned xb_xcc_id() { return (unsigned)__builtin_amdgcn_s_getreg((3 << 11) | 20) & 0xFu; }
#define XB_SPIN(cond, bar) do { unsigned _sp = 0; while (cond) { __builtin_amdgcn_s_sleep(1); \
    if ((++_sp & 255u) == 0u) { if (xb_ld(&(bar)[XB_TMO])) break; if (_sp > XB_SPIN_CAP) { atomicAdd(&(bar)[XB_TMO], 1u); break; } } } } while (0)
struct XcdBarrier { unsigned* bar; unsigned x; volatile LAS unsigned* st; };
__device__ __forceinline__ XcdBarrier xcd_barrier_post(unsigned* bar, volatile LAS unsigned* st) {
  XcdBarrier b; b.bar = bar; b.x = xb_xcc_id(); b.st = st;
  if (threadIdx.x == 0) (void)xb_add(&bar[XB_XCNT(b.x)], 1u);
  return b;
}
__device__ __forceinline__ void xcd_barrier_complete(unsigned* bar, unsigned x, unsigned& nloc, unsigned& nx) {
  const unsigned G = gridDim.x * gridDim.y * gridDim.z;
  unsigned sum, cnt, mine, sp = 0u;
  for (;;) {
    sum = 0u; cnt = 0u; mine = 0u;
#pragma unroll
    for (unsigned j = 0; j < 16; ++j) { const unsigned c = xb_ld(&bar[XB_XCNT(j)]); sum += c; cnt += (c > 0u) ? 1u : 0u; mine = (j == x) ? c : mine; }
    if (sum == G) break;
    __builtin_amdgcn_s_sleep(1);
    if ((++sp & 255u) == 0u) { if (xb_ld(&bar[XB_TMO])) break; if (sp > XB_SPIN_CAP) { atomicAdd(&bar[XB_TMO], 1u); break; } }
  }
  nloc = mine > 0u ? mine : 1u; nx = cnt > 0u ? cnt : 1u;
}
__device__ __forceinline__ void xcd_barrier(const XcdBarrier& b) {
  asm volatile("s_waitcnt vmcnt(0)" ::: "memory");
  __syncthreads();
  if (threadIdx.x == 0) {
    unsigned* bar = b.bar;
    __builtin_amdgcn_s_waitcnt(0);
    unsigned nloc = b.st[0], nx = b.st[1];
    if (nloc == 0u) { xcd_barrier_complete(bar, b.x, nloc, nx); b.st[0] = nloc; b.st[1] = nx; }
    const unsigned old = xb_add(&bar[XB_XSUB(b.x)], 1u);
    const unsigned gen = old / nloc;
    if (old + 1u == (gen + 1u) * nloc) {
      __builtin_amdgcn_fence(__ATOMIC_RELEASE, "agent");
      asm volatile("s_waitcnt vmcnt(0)" ::: "memory");
      const unsigned og = xb_add(&bar[XB_TOP], 1u);
      const unsigned tg = og / nx;
      if (og + 1u == (tg + 1u) * nx) xb_add(&bar[XB_TOPGEN], 1u);
      else XB_SPIN(xb_ld(&bar[XB_TOPGEN]) == tg, bar);
      __builtin_amdgcn_fence(__ATOMIC_ACQUIRE, "agent");
      xb_add(&bar[XB_XGEN(b.x)], 1u);
      asm volatile("s_waitcnt vmcnt(0)" ::: "memory");
    } else {
      XB_SPIN(xb_ld(&bar[XB_XGEN(b.x)]) == gen, bar);
      __builtin_amdgcn_fence(__ATOMIC_ACQUIRE, "agent");
      asm volatile("s_waitcnt vmcnt(0)" ::: "memory");
    }
  }
  __syncthreads();
}

#ifndef PROBE_DUP
#define PROBE_DUP 0
#endif
#define SYNC() do { XcdBarrier xb_; xb_.bar = (unsigned*)(p.ws + OFF_BAR); xb_.x = xb_xcc_id(); xb_.st = (volatile LAS unsigned*)(smem + 147456); xcd_barrier(xb_); } while (0)
__global__ void __launch_bounds__(NT, 2) mega(Params p) {
  extern __shared__ __attribute__((aligned(16))) char smem[];
  if (p.ws == nullptr) cg::this_grid().sync();
  if (threadIdx.x == 0) *(uint4*)(smem + 147456) = make_uint4(0u, 0u, 0u, 0u);
  __syncthreads();
  (void)xcd_barrier_post((unsigned*)(p.ws + OFF_BAR), (volatile LAS unsigned*)(smem + 147456));
  phase0(p, smem);
  SYNC();
  for (int layer = 0; layer < 4; ++layer) {
    phase_norm(p, layer, smem);
    SYNC();
    if (PROBE_DUP & 32) { phase_norm(p, layer, smem); SYNC(); }
    if ((layer & 1) == 0) {
      for (int chunk = 0; chunk < 4; ++chunk) {
        phase_attn_in(p, chunk, smem);
        SYNC();
        if (PROBE_DUP & 16) { phase_attn_in(p, chunk, smem); SYNC(); }
        phase_attn(p, chunk, smem);
        SYNC();
        if (PROBE_DUP & 1) { phase_attn(p, chunk, smem); SYNC(); }
        phase_attn_combine(p, chunk);
        SYNC();
        if (PROBE_DUP & 64) { phase_attn_combine(p, chunk); SYNC(); }
      }
      phase_out_gemm(p, layer, p.ws + OFF_R0, p.ws + OFF_W + WA_OUT * 2, smem);
      SYNC();
    } else {
      int j = layer >> 1;
      phase_ssm_in(p, smem);
      SYNC();
      phase_scan1(p, j, smem);
      SYNC();
      phase_scan2(p, j, smem);
      SYNC();
      phase_ssm_glu(p, smem);
      SYNC();
      if (PROBE_DUP & 128) { phase_ssm_glu(p, smem); SYNC(); }
      phase_out_gemm(p, layer, p.ws + OFF_R1, p.ws + OFF_W + WS_OUT * 2, smem);
      SYNC();
    }
  }
  phase_final_norm(p);
}

extern "C" void kernel_launch(void* const* d_in, const int* in_sizes, int n_in, void* d_out, int out_size,
                              void* d_ws, size_t ws_size, hipStream_t stream) {
  static int grid_blocks = 0;
  if (!grid_blocks) {
    int dev = 0, cus = 0, per_cu = 0;
    hipGetDevice(&dev);
    hipDeviceGetAttribute(&cus, hipDeviceAttributeMultiprocessorCount, dev);
    hipFuncSetAttribute((const void*)mega, hipFuncAttributeMaxDynamicSharedMemorySize, SMEM_BYTES);
    hipOccupancyMaxActiveBlocksPerMultiprocessor(&per_cu, mega, NT, SMEM_BYTES);
    (void)hipGetLastError();
    grid_blocks = cus;
  }
  Params p{};
  p.x_prompt = (const float*)d_in[0]; p.x_sample = (const float*)d_in[1];
  p.c_prompt = (const float*)d_in[2]; p.c_sample = (const float*)d_in[3];
  p.norm_g = (const float*)d_in[4]; p.ada_w = (const float*)d_in[5]; p.ada_b = (const float*)d_in[6];
  p.attn_w_in = (const float*)d_in[7]; p.attn_w_out = (const float*)d_in[8]; p.ssm_w_in = (const float*)d_in[9];
  p.lam_re = (const float*)d_in[10]; p.lam_im = (const float*)d_in[11]; p.log_dt = (const float*)d_in[12];
  p.b_re = (const float*)d_in[13]; p.b_im = (const float*)d_in[14]; p.c_re = (const float*)d_in[15]; p.c_im = (const float*)d_in[16];
  p.ssm_d = (const float*)d_in[17]; p.w_glu = (const float*)d_in[18]; p.w_out = (const float*)d_in[19]; p.final_g = (const float*)d_in[20];
  p.out = (float*)d_out;
  p.ws = (char*)d_ws;
  hipMemsetAsync((char*)d_ws + OFF_BAR, 0, XCD_BAR_WORDS * sizeof(unsigned), stream);
  void* args[] = {&p};
  hipError_t e = hipLaunchCooperativeKernel((void*)mega, dim3(grid_blocks), dim3(NT), args, SMEM_BYTES, stream);
  if (e != hipSuccess) fprintf(stderr, "coop launch failed: %s (grid %d)\n", hipGetErrorString(e), grid_blocks);
}
```
